# Optimizing an MI355X kernel written in HIP

```python
import jax, jax.numpy as jnp
from jax import lax
import numpy as np

D_MODEL = 1024
BATCH = 16
SEQ = 2048
DEPTH = 1

GRID_W = 64
CTX_LEN = 256

MLA_HEADS = 8
MLA_Q_RANK = 256
MLA_KV_RANK = 128
MLA_NOPE = 64
MLA_ROPE = 32
MLA_V = 64
MLA_WIDTH = MLA_HEADS * MLA_V

HG_HEADS = 4
HG_DK = 128
HG_DV = 128
HG_KW = HG_HEADS * HG_DK
HG_WIDTH = HG_HEADS * HG_DV

MIX_WIDTH = MLA_WIDTH + HG_WIDTH
D_FF = 4 * D_MODEL
ROPE_BASE = 10000.0
Q_BLOCK = 128
CHUNK = 64
EPS = 1e-6

IN_SPLITS = (MLA_Q_RANK, MLA_KV_RANK, MLA_ROPE,
             HG_KW, HG_KW, HG_KW, HG_WIDTH, HG_WIDTH)
IN_WIDTH = sum(IN_SPLITS)

kernel_name = "hymba_mla_hgrn2_dit_block"


def rmsnorm(x, g):
    xf = x.astype(jnp.float32)
    xf = xf * lax.rsqrt(jnp.mean(xf * xf, axis=-1, keepdims=True) + EPS)
    return xf.astype(x.dtype) * g


def modulate(h, shift, scale):
    return h * (1 + scale) + shift


def split_cols(p):
    out, start = [], 0
    for n in IN_SPLITS:
        out.append(p[..., start:start + n])
        start += n
    return out


def axial_angles(T):
    rows = T // GRID_W
    row = jnp.repeat(jnp.arange(rows), GRID_W).astype(jnp.float32)
    col = jnp.tile(jnp.arange(GRID_W), rows).astype(jnp.float32)
    n = MLA_ROPE // 4
    inv = ROPE_BASE ** (-jnp.arange(n, dtype=jnp.float32) / n)
    return row[:, None] * inv, col[:, None] * inv


def rotate_half_pairs(x, ang):
    n = x.shape[-1] // 2
    cos = jnp.cos(ang)[:, None, :].astype(x.dtype)
    sin = jnp.sin(ang)[:, None, :].astype(x.dtype)
    x1, x2 = x[..., :n], x[..., n:]
    return jnp.concatenate([x1 * cos - x2 * sin, x2 * cos + x1 * sin], axis=-1)


def rope2d(x, ang_r, ang_c):
    half = MLA_ROPE // 2
    return jnp.concatenate([rotate_half_pairs(x[..., :half], ang_r),
                            rotate_half_pairs(x[..., half:], ang_c)], axis=-1)


def mla_attend(q_nope, q_rope, k_nope, k_rope, v):
    scale = (MLA_NOPE + MLA_ROPE) ** -0.5
    s = (jnp.einsum('bqhd,bkhd->bhqk', q_nope, k_nope)
         + jnp.einsum('bqhr,bkr->bhqk', q_rope, k_rope))
    p = jax.nn.softmax(s.astype(jnp.float32) * scale, axis=-1).astype(v.dtype)
    return jnp.einsum('bhqk,bkhd->bqhd', p, v)


def gated_chunk_scan(q, log_f, k, v, s0):
    B, T, H, _ = q.shape
    DV = v.shape[-1]
    n = T // CHUNK

    def to_chunks(a):
        return a.astype(jnp.float32).reshape(B, n, CHUNK, H, a.shape[-1]).transpose(1, 0, 3, 2, 4)

    mask = jnp.tril(jnp.ones((CHUNK, CHUNK), dtype=bool))[:, :, None]

    def step(S, inp):
        qc, lfc, kc, vc = inp
        b = jnp.cumsum(lfc, axis=2)
        diff = b[:, :, :, None, :] - b[:, :, None, :, :]
        decay = jnp.exp(jnp.where(mask, diff, -jnp.inf))
        a = jnp.einsum('bhtk,bhtsk,bhsk->bhts', qc, decay, kc)
        o = (jnp.einsum('bhts,bhsv->bhtv', a, vc)
             + jnp.einsum('bhtk,bhkv->bhtv', qc * jnp.exp(b), S))
        b_last = b[:, :, -1:, :]
        S = (jnp.exp(b_last[:, :, 0, :])[..., None] * S
             + jnp.einsum('bhsk,bhsv->bhkv', kc * jnp.exp(b_last - b), vc))
        return S, o

    S, o = lax.scan(step, s0, (to_chunks(q), to_chunks(log_f), to_chunks(k), to_chunks(v)))
    o = o.transpose(1, 0, 3, 2, 4).reshape(B, T, H, DV)
    return o, S


def hgrn2_direction(q, zf, i, qc, zfc, ic, lb, reverse):
    def gates(z):
        sig_pos = jax.nn.sigmoid(z.astype(jnp.float32))
        log_f = jnp.log(lb + (1 - lb) * sig_pos)
        k = (1 - lb) * jax.nn.sigmoid(-z.astype(jnp.float32))
        return log_f, k

    lf, k = gates(zf)
    lfc, kc = gates(zfc)
    if reverse:
        q, lf, k, i = [jnp.flip(a, axis=1) for a in (q, lf, k, i)]
        qc, lfc, kc, ic = [jnp.flip(a, axis=1) for a in (qc, lfc, kc, ic)]
    B = q.shape[0]
    s0 = jnp.zeros((B, HG_HEADS, HG_DK, HG_DV), jnp.float32)
    o_c, s_c = gated_chunk_scan(qc, lfc, kc, ic, s0)
    o, _ = gated_chunk_scan(q, lf, k, i, s_c)
    if reverse:
        o, o_c = jnp.flip(o, axis=1), jnp.flip(o_c, axis=1)
    return o, o_c


def mixer(h, hc, ang_r, ang_c, w_in, q_norm, w_uq, kv_norm, w_ukv, lb, hg_norm, w_out, need_ctx):
    B, T, _ = h.shape
    L = hc.shape[1]
    cq, ckv, kr, hq, hf, hb, hi, hg = split_cols(h @ w_in)
    ccq, cckv, ckr, chq, chf, chb, chi, chg = split_cols(hc @ w_in)

    def mla_qkv(cq_, ckv_, kr_, S):
        q = (rmsnorm(cq_, q_norm) @ w_uq).reshape(B, S, MLA_HEADS, MLA_NOPE + MLA_ROPE)
        kv = (rmsnorm(ckv_, kv_norm) @ w_ukv).reshape(B, S, MLA_HEADS, MLA_NOPE + MLA_V)
        return q[..., :MLA_NOPE], q[..., MLA_NOPE:], kv[..., :MLA_NOPE], kv[..., MLA_NOPE:], kr_

    q_nope, q_rope, k_nope, v, k_rope = mla_qkv(cq, ckv, kr, T)
    q_rope = rope2d(q_rope, ang_r, ang_c)
    k_rope = rope2d(k_rope[:, :, None, :], ang_r, ang_c)[:, :, 0, :]
    cq_nope, cq_rope, ck_nope, cv, ck_rope = mla_qkv(ccq, cckv, ckr, L)

    k_all = jnp.concatenate([k_nope, ck_nope], axis=1)
    kr_all = jnp.concatenate([k_rope, ck_rope], axis=1)
    v_all = jnp.concatenate([v, cv], axis=1)

    nb = T // Q_BLOCK

    def blocks(a):
        return a.reshape(B, nb, Q_BLOCK, *a.shape[2:]).swapaxes(0, 1)

    o_mla = lax.map(lambda qs: mla_attend(qs[0], qs[1], k_all, kr_all, v_all),
                    (blocks(q_nope), blocks(q_rope)))
    o_mla = o_mla.swapaxes(0, 1).reshape(B, T, MLA_WIDTH)

    def hg_heads(a, S, d):
        return a.reshape(B, S, HG_HEADS, d)

    q_h, cq_h = jax.nn.silu(hg_heads(hq, T, HG_DK)), jax.nn.silu(hg_heads(chq, L, HG_DK))
    i_h, ci_h = hg_heads(hi, T, HG_DV), hg_heads(chi, L, HG_DV)
    lb_f = lb[0].reshape(HG_HEADS, HG_DK)
    lb_b = lb[1].reshape(HG_HEADS, HG_DK)
    o_f, oc_f = hgrn2_direction(q_h, hg_heads(hf, T, HG_DK), i_h, cq_h, hg_heads(chf, L, HG_DK), ci_h, lb_f, False)
    o_b, oc_b = hgrn2_direction(q_h, hg_heads(hb, T, HG_DK), i_h, cq_h, hg_heads(chb, L, HG_DK), ci_h, lb_b, True)
    o_hg = rmsnorm(o_f + o_b, hg_norm) * jax.nn.silu(hg_heads(hg, T, HG_DV).astype(jnp.float32))
    o_hg = o_hg.reshape(B, T, HG_WIDTH).astype(h.dtype)

    y = jnp.concatenate([o_mla, o_hg], axis=-1) @ w_out

    if not need_ctx:
        return y, None
    oc_mla = mla_attend(cq_nope, cq_rope, ck_nope, ck_rope, cv).reshape(B, L, MLA_WIDTH)
    oc_hg = rmsnorm(oc_f + oc_b, hg_norm) * jax.nn.silu(hg_heads(chg, L, HG_DV).astype(jnp.float32))
    oc_hg = oc_hg.reshape(B, L, HG_WIDTH).astype(hc.dtype)
    yc = jnp.concatenate([oc_mla, oc_hg], axis=-1) @ w_out
    return y, yc


def sq_relu_mlp(h, w1, w2):
    return jnp.square(jax.nn.relu(h @ w1)) @ w2


def setup_inputs(seed: int = 0) -> dict:
    key = jax.random.key(seed)
    ks = jax.random.split(key, 20)
    f32 = jnp.float32

    def nrm(k, shape, scale):
        return jax.random.normal(k, shape, f32) * scale

    def gain(k, shape):
        return 1.0 + 0.02 * jax.random.normal(k, shape, f32)

    return {
        "x": nrm(ks[0], (BATCH, SEQ, D_MODEL), 1.0),
        "c": nrm(ks[1], (BATCH, D_MODEL), 1.0),
        "ctx": nrm(ks[2], (BATCH, CTX_LEN, D_MODEL), 1.0),
        "c_ctx": nrm(ks[3], (D_MODEL,), 1.0),
        "w_ada": nrm(ks[4], (DEPTH, D_MODEL, 6 * D_MODEL), 0.01),
        "b_ada": nrm(ks[5], (DEPTH, 6 * D_MODEL), 0.01),
        "norm_mix": gain(ks[6], (DEPTH, D_MODEL)),
        "w_in": nrm(ks[7], (DEPTH, D_MODEL, IN_WIDTH), D_MODEL ** -0.5),
        "q_norm": gain(ks[8], (DEPTH, MLA_Q_RANK)),
        "w_uq": nrm(ks[9], (DEPTH, MLA_Q_RANK, MLA_HEADS * (MLA_NOPE + MLA_ROPE)), MLA_Q_RANK ** -0.5),
        "kv_norm": gain(ks[10], (DEPTH, MLA_KV_RANK)),
        "w_ukv": nrm(ks[11], (DEPTH, MLA_KV_RANK, MLA_HEADS * (MLA_NOPE + MLA_V)), MLA_KV_RANK ** -0.5),
        "hgrn_lb": nrm(ks[12], (DEPTH + 1, 2, HG_KW), 0.1),
        "hgrn_norm": gain(ks[13], (DEPTH, HG_DV)),
        "w_out": nrm(ks[14], (DEPTH, MIX_WIDTH, D_MODEL), MIX_WIDTH ** -0.5),
        "norm_mlp": gain(ks[15], (DEPTH, D_MODEL)),
        "w_mlp_in": nrm(ks[16], (DEPTH, D_MODEL, D_FF), D_MODEL ** -0.5),
        "w_mlp_out": nrm(ks[17], (DEPTH, D_FF, D_MODEL), D_FF ** -0.5),
        "final_norm": gain(ks[18], (D_MODEL,)),
    }


def reference(x, c, ctx, c_ctx, w_ada, b_ada, norm_mix, w_in, q_norm, w_uq, kv_norm, w_ukv,
              hgrn_lb, hgrn_norm, w_out, norm_mlp, w_mlp_in, w_mlp_out, final_norm):
    T = x.shape[1]
    ang_r, ang_c = axial_angles(T)
    lb_all = jnp.cumsum(jax.nn.softmax(hgrn_lb.astype(jnp.float32), axis=0), axis=0)
    s_lat = jax.nn.silu(c)
    s_ctx = jax.nn.silu(c_ctx)
    z = ctx
    for l in range(DEPTH):
        need_ctx = l < DEPTH - 1
        mod = s_lat @ w_ada[l] + b_ada[l]
        mod_c = s_ctx @ w_ada[l] + b_ada[l]
        sh1, sc1, g1, sh2, sc2, g2 = [m[:, None, :] for m in jnp.split(mod, 6, axis=-1)]
        csh1, csc1, cg1, csh2, csc2, cg2 = jnp.split(mod_c, 6, axis=-1)

        h = modulate(rmsnorm(x, norm_mix[l]), sh1, sc1)
        hc = modulate(rmsnorm(z, norm_mix[l]), csh1, csc1)
        y, yc = mixer(h, hc, ang_r, ang_c, w_in[l], q_norm[l], w_uq[l], kv_norm[l], w_ukv[l],
                      lb_all[l], hgrn_norm[l], w_out[l], need_ctx)
        x = x + g1 * y
        x = x + g2 * sq_relu_mlp(modulate(rmsnorm(x, norm_mlp[l]), sh2, sc2), w_mlp_in[l], w_mlp_out[l])
        if need_ctx:
            z = z + cg1 * yc
            z = z + cg2 * sq_relu_mlp(modulate(rmsnorm(z, norm_mlp[l]), csh2, csc2), w_mlp_in[l], w_mlp_out[l])
    return rmsnorm(x, final_norm)
```

```cpp
#include <hip/hip_runtime.h>
#include <hip/hip_cooperative_groups.h>
#include <cstdio>
#include <cstdint>
namespace cg = cooperative_groups;
#ifndef REP_HG
#define REP_HG 0
#endif
#ifndef REP_AT
#define REP_AT 0
#endif
#ifndef REP_MASK
#define REP_MASK 0
#endif
__device__ __forceinline__ int lane_id_opaque() { int l; asm volatile("v_mbcnt_lo_u32_b32 %0, -1, 0\n\tv_mbcnt_hi_u32_b32 %0, -1, %0" : "=v"(l)); return l; }
#ifndef REP_BAR
#define REP_BAR 0
#endif
namespace pg8 {
#define PG8_LAS __attribute__((address_space(3)))
typedef unsigned short bf16_t;
typedef short bf16x8 __attribute__((ext_vector_type(8)));
typedef float f32x4 __attribute__((ext_vector_type(4)));
typedef unsigned u32x4 __attribute__((ext_vector_type(4)));
constexpr int BM = 256, BK = 64, HALF = 128, HTB = HALF * BK * 2  , STAGE_BYTES = 8 * HTB, NXCD = 8, WGM = 8;

__host__ __device__ __forceinline__ int lds_byte(int r, int c) { const int st = (r >> 4) * 2 + (c >> 5), rr = r & 15, cc = c & 31, ob = rr * 64 + cc * 2; return st * 1024 + (ob ^ (((ob >> 9) & 1) << 5)); }
__host__ __device__ __forceinline__ void stage_rc(int b, int& R, int& C) { const int st = b / 1024, sb = b % 1024, swz = sb ^ (((sb >> 9) & 1) << 5); R = (st >> 1) * 16 + swz / 64; C = (st & 1) * 32 + (swz % 64) / 2; }
__host__ __device__ __forceinline__ int perm32(int rho) { const int n = rho >> 4, i = rho & 15; return 8 * (i >> 2) + 4 * n + (i & 3); }

struct Unit { int pm, pn; };
struct Gemm { const bf16_t* A; int lda; const bf16_t* Bt; int M, N, K; };

struct StaticOrder {
    int nM, nN, nwg, G, c;
    __host__ __device__ void init(int M, int N, int G_, int c_) { nM = M / BM; nN = N / BM; nwg = nM * nN; G = G_; c = c_; }
    __host__ __device__ bool next(int i, Unit& u) const {
        const long L = (long)i * G + c; if (L >= nwg) return false;
        int wgid = (int)L; { const int q = nwg / NXCD, r = nwg % NXCD, xcd = wgid % NXCD, off = wgid / NXCD; wgid = (xcd < r ? xcd * (q + 1) : r * (q + 1) + (xcd - r) * q) + off; }
        const int nig = WGM * nN, gid = wgid / nig, fm = gid * WGM, gsz = (nM - fm) < WGM ? (nM - fm) : WGM;
        u.pm = fm + ((wgid % nig) % gsz); u.pn = (wgid % nig) / gsz; return true;
    }
    __device__ __forceinline__ void a_ready(const Unit&) const {}
    __device__ __forceinline__ void done(const Unit&) const {}
};

__device__ __forceinline__ unsigned cvt_pk_bf16(float lo, float hi) { unsigned r; asm volatile("v_cvt_pk_bf16_f32 %0, %1, %2" : "=v"(r) : "v"(lo), "v"(hi)); return r; }
typedef float f32x2 __attribute__((ext_vector_type(2)));
__device__ __forceinline__ f32x2 gelu_pk(f32x2 v) {
    const f32x2 av = __builtin_elementwise_abs(v), d = av * 0.2316418882f + 1.0f;
    f32x2 t; t.x = __builtin_amdgcn_rcpf(d.x); t.y = __builtin_amdgcn_rcpf(d.y);
    f32x2 q = t * 0.5307027145f + (-0.7265760135f); q = q * t + 0.7107068705f; q = q * t + (-0.142248368f); q = q * t + 0.127414796f; q = q * t;
    const f32x2 s = (v * v) * (-0.72134752044f);
    f32x2 e; e.x = __builtin_amdgcn_exp2f(s.x); e.y = __builtin_amdgcn_exp2f(s.y);
    const f32x2 m = v * (q * e), r = v - m;
    f32x2 o; o.x = v.x < 0.f ? m.x : r.x; o.y = v.y < 0.f ? m.y : r.y; return o;
}

template <int ACT  > struct EpiBf16 {
    static constexpr bool PERM = true, AFTER_DRAIN = false; static_assert(ACT == 0 || ACT == 1, "EpiBf16: ACT is 0 (none) or 1 (gelu_pk)");
    bf16_t* O; int ldc; const float* bias; int split_cols; size_t split_stride; float scale0;
    __device__ __forceinline__ void operator()(const f32x4 (&acc)[2][2][4][2], const Unit& u, int wr, int wc, int fr, int fq) const {
        const int row0 = u.pm * BM + wr * 64 + fr; int colt = u.pn * BM; bf16_t* base = O;
        float sc = 1.f; if (split_cols) { const int t = colt / split_cols; base += (size_t)t * split_stride; colt -= t * split_cols; if (t == 0) sc = scale0; }
        const int col0 = colt + wc * 32 + 8 * fq, bcol0 = u.pn * BM + wc * 32 + 8 * fq;
        f32x4 bv[2][2];
#pragma unroll
        for (int bj = 0; bj < 2; ++bj)
#pragma unroll
            for (int n = 0; n < 2; ++n) bv[bj][n] = bias ? *(const f32x4*)(bias + bcol0 + bj * HALF + 4 * n) : (f32x4){0.f, 0.f, 0.f, 0.f};
#pragma unroll
        for (int ai = 0; ai < 2; ++ai)
#pragma unroll
            for (int m = 0; m < 4; ++m) { bf16_t* rowp = base + (size_t)(row0 + ai * HALF + m * 16) * ldc + col0;
#pragma unroll
                for (int bj = 0; bj < 2; ++bj) { f32x4 v0 = acc[ai][bj][m][0] + bv[bj][0], v1 = acc[ai][bj][m][1] + bv[bj][1];
                    if (ACT == 1) { f32x2 a = gelu_pk((f32x2){v0[0], v0[1]}), b = gelu_pk((f32x2){v0[2], v0[3]}), c = gelu_pk((f32x2){v1[0], v1[1]}), d = gelu_pk((f32x2){v1[2], v1[3]});
                        v0 = (f32x4){a.x, a.y, b.x, b.y}; v1 = (f32x4){c.x, c.y, d.x, d.y}; }
                    v0 = v0 * sc; v1 = v1 * sc; u32x4 w; w.x = cvt_pk_bf16(v0[0], v0[1]); w.y = cvt_pk_bf16(v0[2], v0[3]); w.z = cvt_pk_bf16(v1[0], v1[1]); w.w = cvt_pk_bf16(v1[2], v1[3]);
                    *(u32x4*)(rowp + bj * HALF) = w; } }
    }
};
constexpr int NLAT_ROWS = 32768;
struct EpiKV {
    static constexpr bool PERM = true, AFTER_DRAIN = false;
    bf16_t* Kb; bf16_t* Vt;
    __device__ __forceinline__ void operator()(const f32x4 (&acc)[2][2][4][2], const Unit& u, int wr, int wc, int fr_in, int fq_in) const {
        int fr = fr_in, fq = fq_in; asm volatile("" : "+v"(fr), "+v"(fq));
        const int rbase = u.pm * BM; int b, keybase;
        if (rbase < NLAT_ROWS) { b = rbase >> 11; keybase = rbase & 2047; } else { b = (rbase - NLAT_ROWS) >> 8; keybase = 2048 + ((rbase - NLAT_ROWS) & 255); }
        const int rl0 = wr * 64 + fr; const int colt = u.pn * BM + wc * 32 + 8 * fq;
#pragma unroll
        for (int ai = 0; ai < 2; ++ai)
#pragma unroll
            for (int m = 0; m < 4; ++m) { const int rl = rl0 + ai * HALF + m * 16; const size_t row = (size_t)(rbase + rl);
#pragma unroll
                for (int bj = 0; bj < 2; ++bj) { const f32x4 v0 = acc[ai][bj][m][0], v1 = acc[ai][bj][m][1]; const int c = colt + bj * HALF;
                    u32x4 w; w.x = cvt_pk_bf16(v0[0], v0[1]); w.y = cvt_pk_bf16(v0[2], v0[3]); w.z = cvt_pk_bf16(v1[0], v1[1]); w.w = cvt_pk_bf16(v1[2], v1[3]);
                    if (u.pn < 2) { const int h = c >> 6, d = c & 63; *(u32x4*)(Kb + row * 768 + h * 96 + d) = w; }
                    else { const int cv = c - 512, h = cv >> 6, d = cv & 63; const int kk_ = keybase + rl, kp_ = (kk_ & ~12) | ((kk_ & 4) << 1) | ((kk_ & 8) >> 1); bf16_t* p = Vt + ((size_t)((b * 8 + h) * 64 + d)) * 2304 + kp_;
                        p[0] = (bf16_t)(w.x & 0xffffu); p[2304] = (bf16_t)(w.x >> 16); p[2 * 2304] = (bf16_t)(w.y & 0xffffu); p[3 * 2304] = (bf16_t)(w.y >> 16);
                        p[4 * 2304] = (bf16_t)(w.z & 0xffffu); p[5 * 2304] = (bf16_t)(w.z >> 16); p[6 * 2304] = (bf16_t)(w.w & 0xffffu); p[7 * 2304] = (bf16_t)(w.w >> 16); } } }
    }
};
struct EpiRes {
    static constexpr bool PERM = false, AFTER_DRAIN = false;
    const float* base; float* out; const float* gate;
    __device__ __forceinline__ void operator()(const f32x4 (&acc)[2][2][4][2], const Unit& u, int wr, int wc, int fr_in, int fq_in) const {
        int fr = fr_in, fq = fq_in; asm volatile("" : "+v"(fr), "+v"(fq));
        const int row0 = u.pm * BM + wr * 64 + fr, col0 = u.pn * BM + wc * 32 + 4 * fq;
        const float* gp = gate + (size_t)((u.pm * BM) >> 11) * 6144 + col0;
        f32x4 gv[2][2];
#pragma unroll
        for (int bj = 0; bj < 2; ++bj)
#pragma unroll
            for (int n = 0; n < 2; ++n) gv[bj][n] = *(const f32x4*)(gp + bj * HALF + n * 16);
        f32x4 cur[2][2], nxt[2][2];
#pragma unroll
        for (int bj = 0; bj < 2; ++bj)
#pragma unroll
            for (int n = 0; n < 2; ++n) { cur[bj][n] = *(const f32x4*)(base + (size_t)row0 * 1024 + col0 + bj * HALF + n * 16); nxt[bj][n] = cur[bj][n]; }
#pragma unroll
        for (int i = 0; i < 8; ++i) { const int ai = i >> 2, m = i & 3; const size_t off = (size_t)(row0 + ai * HALF + m * 16) * 1024 + col0;
            if (i + 1 < 8) { const size_t offn = (size_t)(row0 + ((i + 1) >> 2) * HALF + ((i + 1) & 3) * 16) * 1024 + col0;
#pragma unroll
                for (int bj = 0; bj < 2; ++bj)
#pragma unroll
                    for (int n = 0; n < 2; ++n) nxt[bj][n] = *(const f32x4*)(base + offn + bj * HALF + n * 16);
                asm volatile("" ::: "memory"); }
#pragma unroll
            for (int bj = 0; bj < 2; ++bj)
#pragma unroll
                for (int n = 0; n < 2; ++n) { *(f32x4*)(out + off + bj * HALF + n * 16) = cur[bj][n] + gv[bj][n] * acc[ai][bj][m][n]; cur[bj][n] = nxt[bj][n]; }
            asm volatile("" ::: "memory"); }
    }
};
struct EpiRelu2 {
    static constexpr bool PERM = true, AFTER_DRAIN = false;
    bf16_t* O; int ldc;
    __device__ __forceinline__ void operator()(const f32x4 (&acc)[2][2][4][2], const Unit& u, int wr, int wc, int fr_in, int fq_in) const {
        int fr = fr_in, fq = fq_in; asm volatile("" : "+v"(fr), "+v"(fq));
        const int row0 = u.pm * BM + wr * 64 + fr, col0 = u.pn * BM + wc * 32 + 8 * fq;
#pragma unroll
        for (int ai = 0; ai < 2; ++ai)
#pragma unroll
            for (int m = 0; m < 4; ++m) { bf16_t* rowp = O + (size_t)(row0 + ai * HALF + m * 16) * ldc + col0;
#pragma unroll
                for (int bj = 0; bj < 2; ++bj) { f32x4 v0 = acc[ai][bj][m][0], v1 = acc[ai][bj][m][1];
#pragma unroll
                    for (int e = 0; e < 4; ++e) { const float a = fmaxf(v0[e], 0.f), b2 = fmaxf(v1[e], 0.f); v0[e] = a * a; v1[e] = b2 * b2; }
                    u32x4 w; w.x = cvt_pk_bf16(v0[0], v0[1]); w.y = cvt_pk_bf16(v0[2], v0[3]); w.z = cvt_pk_bf16(v1[0], v1[1]); w.w = cvt_pk_bf16(v1[2], v1[3]);
                    *(u32x4*)(rowp + bj * HALF) = w; } }
    }
};
struct EpiIn {
    static constexpr bool PERM = true, AFTER_DRAIN = false;
    bf16_t* O; const float* lbraw;
    __device__ __forceinline__ void operator()(const f32x4 (&acc)[2][2][4][2], const Unit& u, int wr, int wc, int fr_in, int fq_in) const {
        int fr = fr_in, fq = fq_in; asm volatile("" : "+v"(fr), "+v"(fq));
        const int row0 = u.pm * BM + wr * 64 + fr, col0 = u.pn * BM + wc * 32 + 8 * fq; const int mode = (u.pn >= 4 && u.pn < 8) ? 2 : ((u.pn == 2 || u.pn == 3) ? 1 : 0);
        float lb[2][8];
#pragma unroll
        for (int bj = 0; bj < 2; ++bj)
#pragma unroll
            for (int e8 = 0; e8 < 8; ++e8) lb[bj][e8] = 0.5f;
        if (mode == 2) { const int dir = u.pn >= 6, cb = (u.pn - (dir ? 6 : 4)) * BM + wc * 32 + 8 * fq;
#pragma unroll
            for (int bj = 0; bj < 2; ++bj)
#pragma unroll
                for (int e8 = 0; e8 < 8; ++e8) { const float a0 = lbraw[dir * 512 + cb + bj * HALF + e8], a1 = lbraw[1024 + dir * 512 + cb + bj * HALF + e8]; const float e0 = __expf(a0), e1 = __expf(a1); lb[bj][e8] = e0 / (e0 + e1); } }
#pragma unroll
        for (int ai = 0; ai < 2; ++ai)
#pragma unroll
            for (int m = 0; m < 4; ++m) { bf16_t* rowp = O + (size_t)(row0 + ai * HALF + m * 16) * 3072 + col0;
#pragma unroll
                for (int bj = 0; bj < 2; ++bj) { float v[8];
#pragma unroll
                    for (int e8 = 0; e8 < 8; ++e8) v[e8] = acc[ai][bj][m][e8 >> 2][e8 & 3];
                    if (mode == 1) {
#pragma unroll
                        for (int e8 = 0; e8 < 8; ++e8) v[e8] = v[e8] * __builtin_amdgcn_rcpf(1.f + __expf(-v[e8]));
                    } else if (mode == 2) {
#pragma unroll
                        for (int e8 = 0; e8 < 8; ++e8) { const float sg = __builtin_amdgcn_rcpf(1.f + __expf(-v[e8])); v[e8] = __logf(lb[bj][e8] + (1.f - lb[bj][e8]) * sg); }
                    }
                    u32x4 w; w.x = cvt_pk_bf16(v[0], v[1]); w.y = cvt_pk_bf16(v[2], v[3]); w.z = cvt_pk_bf16(v[4], v[5]); w.w = cvt_pk_bf16(v[6], v[7]);
                    *(u32x4*)(rowp + bj * HALF) = w; } }
    }
};
template <class Epi, class Sched, bool ALIGN_EPI = false, bool SP2 = false>
__device__ __forceinline__ void gemm_phase(PG8_LAS unsigned char* lds, const Gemm g, const Sched& S, const Epi& E, const int wave_s) {
    const int wid = wave_s, lane = lane_id_opaque(), tid = wid * 64 + lane, wr = wid >> 2, wc = wid & 3, fr = lane & 15, fq = lane >> 4;
    const int K = g.K, nt = K / BK;
    unsigned voffA[2], voffB[2];
#pragma unroll
    for (int i = 0; i < 2; ++i) { int R, C; stage_rc(tid * 16 + i * 8192, R, C); const int Rb = Epi::PERM ? ((R & ~31) + perm32(R & 31)) : R;
        voffA[i] = (unsigned)(R * g.lda + C) * 2u; voffB[i] = (unsigned)(Rb * K + C) * 2u; }
    const size_t kstep = (size_t)(BK * 2);
    const size_t hstepA = (size_t)HALF * g.lda * 2, hstepB = (size_t)HALF * K * 2;
    const size_t tstepA = 2 * hstepA, tstepB = 2 * hstepB;
    const unsigned ldsw = (unsigned)wid * 1024u;
    const int aoff = lds_byte(wr * 64 + fr, fq * 8), boff = lds_byte(wc * 32 + fr, fq * 8);
#define PG8_SA(b, h) (((b) * 2 + (h)) * HTB)
#define PG8_SB(b, h) ((4 + (b) * 2 + (h)) * HTB)
#define PG8_STAGE(bufoff, gbase, voff) do { _Pragma("unroll") for (int _i = 0; _i < 2; ++_i) \
        __builtin_amdgcn_global_load_lds((const unsigned*)((const char*)(gbase) + (voff)[_i]), (PG8_LAS unsigned*)(lds + (bufoff) + ldsw + _i * 8192), 16, 0, 0); } while (0)
#define PG8_LDA(dst, b, h) do { _Pragma("unroll") for (int m = 0; m < 4; ++m) _Pragma("unroll") for (int k = 0; k < 2; ++k) dst[m][k] = *(const PG8_LAS bf16x8*)(lds + PG8_SA(b, h) + aoff + m * 2048 + k * 1024); } while (0)
#define PG8_LDB(dst, b, h) do { _Pragma("unroll") for (int n = 0; n < 2; ++n) _Pragma("unroll") for (int k = 0; k < 2; ++k) dst[n][k] = *(const PG8_LAS bf16x8*)(lds + PG8_SB(b, h) + boff + n * 2048 + k * 1024); } while (0)
#define PG8_MMA(ai, bj, At, Bt) do { __builtin_amdgcn_s_setprio(1); _Pragma("unroll") for (int m = 0; m < 4; ++m) _Pragma("unroll") for (int n = 0; n < 2; ++n) _Pragma("unroll") for (int k = 0; k < 2; ++k) \
        acc[ai][bj][m][n] = __builtin_amdgcn_mfma_f32_16x16x32_bf16(Bt[n][k], At[m][k], acc[ai][bj][m][n], 0, 0, 0); __builtin_amdgcn_s_setprio(0); } while (0)
#define PG8_WAIT_V(n) asm volatile("s_waitcnt vmcnt(" #n ")" ::: "memory")
#define PG8_WAIT_L(n) asm volatile("s_waitcnt lgkmcnt(" #n ")" ::: "memory")
#define PG8_BAR __builtin_amdgcn_s_barrier()
#define PG8_SCHED __builtin_amdgcn_sched_barrier(0)
    Unit cur, nxt; int ui = 0;
    if (!S.next(0, cur)) return;
    f32x4 acc[2][2][4][2];
#pragma unroll
    for (int a = 0; a < 2; ++a)
#pragma unroll
        for (int b = 0; b < 2; ++b)
#pragma unroll
            for (int m = 0; m < 4; ++m)
#pragma unroll
                for (int n = 0; n < 2; ++n) acc[a][b][m][n] = (f32x4){0.f, 0.f, 0.f, 0.f};
    bf16x8 At[4][2], B0[2][2], B1[2][2];
    const char* cA = (const char*)g.A + (size_t)cur.pm * tstepA; const char* cB = (const char*)g.Bt + (size_t)cur.pn * tstepB;
    S.a_ready(cur);
    if constexpr (SP2) {
        PG8_STAGE(PG8_SB(0, 0), cB, voffB); PG8_STAGE(PG8_SB(0, 1), cB + hstepB, voffB); PG8_STAGE(PG8_SA(0, 0), cA, voffA); PG8_STAGE(PG8_SA(0, 1), cA + hstepA, voffA);
        if (wr == 1) PG8_BAR;
        PG8_WAIT_V(2); PG8_BAR;
        PG8_STAGE(PG8_SB(1, 0), cB + kstep, voffB); PG8_STAGE(PG8_SA(1, 0), cA + kstep, voffA); PG8_STAGE(PG8_SB(1, 1), cB + hstepB + kstep, voffB);
        PG8_WAIT_V(6); PG8_BAR;
    } else {
        PG8_STAGE(PG8_SB(0, 0), cB, voffB); PG8_STAGE(PG8_SA(0, 0), cA, voffA); PG8_STAGE(PG8_SB(0, 1), cB + hstepB, voffB); PG8_STAGE(PG8_SA(0, 1), cA + hstepA, voffA);
        if (wr == 1) PG8_BAR;
        PG8_WAIT_V(4); PG8_BAR;
        PG8_STAGE(PG8_SB(1, 0), cB + kstep, voffB); PG8_STAGE(PG8_SA(1, 0), cA + kstep, voffA); PG8_STAGE(PG8_SB(1, 1), cB + hstepB + kstep, voffB);
        PG8_WAIT_V(6); PG8_BAR;
    }
    for (;;) {
        const bool has_next = S.next(ui + 1, nxt);
        const char* nA = has_next ? (const char*)g.A + (size_t)nxt.pm * tstepA : cA; const char* nB = has_next ? (const char*)g.Bt + (size_t)nxt.pn * tstepB : cB;
        for (int t = 0; t < nt; t += 2) {
            const bool last = (t == nt - 2);
            const char* a1 = cA + (size_t)(t + 1) * kstep;
            const char* a2 = last ? nA : cA + (size_t)(t + 2) * kstep; const char* b2 = last ? nB : cB + (size_t)(t + 2) * kstep;
            const char* a3 = a2 + kstep; const char* b3 = b2 + kstep;
            if (last && has_next) S.a_ready(nxt);
            if constexpr (SP2) {
            PG8_LDB(B0, 0, 0); PG8_LDB(B1, 0, 1); PG8_SCHED; PG8_LDA(At, 0, 0); PG8_STAGE(PG8_SA(1, 1), a1 + hstepA, voffA);
            PG8_WAIT_V(8); PG8_WAIT_L(0); PG8_BAR; PG8_MMA(0, 0, At, B0); PG8_MMA(0, 1, At, B1); PG8_BAR; PG8_SCHED;
            PG8_LDA(At, 0, 1); PG8_STAGE(PG8_SB(0, 0), b2, voffB); PG8_STAGE(PG8_SB(0, 1), b2 + hstepB, voffB); PG8_STAGE(PG8_SA(0, 0), a2, voffA);
            PG8_WAIT_V(8); PG8_WAIT_L(0); PG8_BAR; PG8_MMA(1, 0, At, B0); PG8_MMA(1, 1, At, B1); PG8_BAR; PG8_SCHED;
            PG8_LDB(B0, 1, 0); PG8_LDB(B1, 1, 1); PG8_SCHED; PG8_LDA(At, 1, 0); PG8_STAGE(PG8_SA(0, 1), a2 + hstepA, voffA);
            PG8_WAIT_V(8); PG8_WAIT_L(0); PG8_BAR; PG8_MMA(0, 0, At, B0); PG8_MMA(0, 1, At, B1); PG8_BAR; PG8_SCHED;
            PG8_LDA(At, 1, 1); PG8_STAGE(PG8_SB(1, 0), b3, voffB); PG8_STAGE(PG8_SB(1, 1), b3 + hstepB, voffB); PG8_STAGE(PG8_SA(1, 0), a3, voffA);
            PG8_WAIT_V(8); PG8_WAIT_L(0); PG8_BAR; PG8_MMA(1, 0, At, B0); PG8_MMA(1, 1, At, B1); PG8_BAR; PG8_SCHED;
            } else {
            PG8_LDB(B0, 0, 0); PG8_SCHED; PG8_LDA(At, 0, 0); PG8_STAGE(PG8_SA(1, 1), a1 + hstepA, voffA);
            PG8_WAIT_L(8); PG8_BAR; PG8_WAIT_L(0); PG8_MMA(0, 0, At, B0); PG8_BAR; PG8_SCHED;
            PG8_LDB(B1, 0, 1); PG8_STAGE(PG8_SB(0, 0), b2, voffB);
            PG8_BAR; PG8_WAIT_L(0); PG8_MMA(0, 1, At, B1); PG8_BAR;
            PG8_LDA(At, 0, 1); PG8_STAGE(PG8_SA(0, 0), a2, voffA);
            PG8_BAR; PG8_WAIT_L(0); PG8_MMA(1, 0, At, B0); PG8_BAR; PG8_SCHED;
            PG8_STAGE(PG8_SB(0, 1), b2 + hstepB, voffB);
            PG8_WAIT_V(6); PG8_BAR; PG8_MMA(1, 1, At, B1); PG8_BAR;
            PG8_LDB(B0, 1, 0); PG8_SCHED; PG8_LDA(At, 1, 0); PG8_STAGE(PG8_SA(0, 1), a2 + hstepA, voffA);
            PG8_WAIT_L(8); PG8_BAR; PG8_WAIT_L(0); PG8_MMA(0, 0, At, B0); PG8_BAR; PG8_SCHED;
            PG8_LDB(B1, 1, 1); PG8_STAGE(PG8_SB(1, 0), b3, voffB);
            PG8_BAR; PG8_WAIT_L(0); PG8_MMA(0, 1, At, B1); PG8_BAR;
            PG8_LDA(At, 1, 1); PG8_STAGE(PG8_SA(1, 0), a3, voffA);
            PG8_BAR; PG8_WAIT_L(0); PG8_MMA(1, 0, At, B0); PG8_BAR; PG8_SCHED;
            PG8_STAGE(PG8_SB(1, 1), b3 + hstepB, voffB);
            PG8_WAIT_V(6); PG8_BAR; PG8_MMA(1, 1, At, B1); PG8_BAR;
            }
        }
        if constexpr (ALIGN_EPI) { if (wr == 0) PG8_BAR; }
        if constexpr (!Epi::AFTER_DRAIN) { E(acc, cur, wr, wc, fr, fq); S.done(cur); }
        if (!has_next) break;
#pragma unroll
        for (int a = 0; a < 2; ++a)
#pragma unroll
            for (int b = 0; b < 2; ++b)
#pragma unroll
                for (int m = 0; m < 4; ++m)
#pragma unroll
                    for (int n = 0; n < 2; ++n) acc[a][b][m][n] = (f32x4){0.f, 0.f, 0.f, 0.f};
        cur = nxt; cA = nA; cB = nB; ++ui;
        if constexpr (ALIGN_EPI) { if (wr == 1) PG8_BAR; }
    }
    PG8_WAIT_V(0);
    if constexpr (!ALIGN_EPI) { if (wr == 0) PG8_BAR; }
    PG8_BAR;
    if constexpr (Epi::AFTER_DRAIN) { E.fused(acc, cur, wr, wc, fr, fq, lds, wid, lane); S.done(cur); }
#undef PG8_SA
#undef PG8_SB
#undef PG8_STAGE
#undef PG8_LDA
#undef PG8_LDB
#undef PG8_MMA
#undef PG8_WAIT_V
#undef PG8_WAIT_L
#undef PG8_BAR
#undef PG8_SCHED
}
}
#define LAS __attribute__((address_space(3)))
typedef unsigned short bf16;
typedef unsigned u32x4 __attribute__((ext_vector_type(4)));
typedef unsigned u32x2 __attribute__((ext_vector_type(2)));
typedef float f32x4 __attribute__((ext_vector_type(4)));
typedef float f32x16 __attribute__((ext_vector_type(16)));
typedef short bf16x8 __attribute__((ext_vector_type(8)));
typedef short s16x4 __attribute__((ext_vector_type(4)));
typedef float f32x2_t __attribute__((ext_vector_type(2)));
typedef __bf16 bf16x2_t __attribute__((ext_vector_type(2)));

constexpr int NB = 16, TSEQ = 2048, LCTX = 256, DM = 1024, NLAT = NB * TSEQ, NCTXR = NB * LCTX, MALL = NLAT + NCTXR, DFF = 4096;
constexpr int NP = 3072;
constexpr int PC_CQ = 0, PC_CKV = 256, PC_KR = 384, PC_HQ = 512, PC_HF = 1024, PC_HB = 1536, PC_HI = 2048, PC_HG = 2560;
constexpr int NKEY = TSEQ + LCTX;
constexpr float EPS = 1e-6f;
constexpr float QSCALE = 0.10206207261596575f * 1.4426950408889634f;
constexpr size_t MiB = 1u << 20;
constexpr size_t WS_WIN = 1 * MiB, WS_WUQ = 7 * MiB, WS_WUKV = 7 * MiB + 512 * 1024, WS_WOUT = 8 * MiB, WS_W1 = 10 * MiB, WS_W2 = 18 * MiB, WS_MOD = 26 * MiB;
constexpr size_t WS_XN = 32 * MiB, WS_P = 104 * MiB, WS_Q = 320 * MiB, WS_K = 368 * MiB, WS_VT = 422 * MiB, WS_END = 458 * MiB, WS_HID = 104 * MiB;
constexpr int LDS_BYTES = 139264;

__device__ __forceinline__ unsigned cvtpk(float lo, float hi) { f32x2_t v = {lo, hi}; bf16x2_t b = __builtin_convertvector(v, bf16x2_t); return __builtin_bit_cast(unsigned, b); }
__device__ __forceinline__ bf16 f2b(float x) { return (bf16)(cvtpk(x, 0.f) & 0xffffu); }
__device__ __forceinline__ float b2f(unsigned short v) { return __builtin_bit_cast(float, (unsigned)v << 16); }
__device__ __forceinline__ float blo(unsigned w) { return __builtin_bit_cast(float, w << 16); }
__device__ __forceinline__ float bhi(unsigned w) { return __builtin_bit_cast(float, w & 0xffff0000u); }
__device__ __forceinline__ float wave_sum(float v) {
#pragma unroll
    for (int o = 1; o < 64; o <<= 1) v += __shfl_xor(v, o);
    return v;
}
__device__ __forceinline__ float sigmoidf_(float x) { return __builtin_amdgcn_rcpf(1.f + __expf(-x)); }
#define LDS_BARRIER() asm volatile("s_waitcnt lgkmcnt(0)\n\ts_barrier" ::: "memory")

struct Params {
    const float *x, *c, *ctx, *c_ctx, *w_ada, *b_ada, *norm_mix, *w_in, *q_norm, *w_uq, *kv_norm, *w_ukv, *hgrn_lb, *hgrn_norm, *w_out, *norm_mlp, *w_mlp_in, *w_mlp_out, *final_norm;
    float* out; unsigned char* ws; int ph_lo, ph_hi, coop, pad;
};

__device__ __forceinline__ void tr_item(const float* __restrict__ W, int K, int N, bf16* WT, int dst_row0, int k0, int n0, const float* gain, LAS float* scr, int lane) {
#pragma unroll 8
    for (int i = 0; i < 32; ++i) { const int kk = 2 * i + (lane >> 5); float v = W[(size_t)(k0 + kk) * N + n0 + (lane & 31)]; if (gain) v *= gain[k0 + kk]; scr[kk * 33 + (lane & 31)] = v; }
    asm volatile("s_waitcnt lgkmcnt(0)" ::: "memory");
    const int c = lane & 7;
#pragma unroll
    for (int j = 0; j < 4; ++j) { const int n = (lane >> 3) + 8 * j; const LAS float* s = scr + (8 * c) * 33 + n;
        u32x4 o; o.x = cvtpk(s[0 * 33], s[1 * 33]); o.y = cvtpk(s[2 * 33], s[3 * 33]); o.z = cvtpk(s[4 * 33], s[5 * 33]); o.w = cvtpk(s[6 * 33], s[7 * 33]);
        *(u32x4*)(WT + (size_t)(dst_row0 + n) * K + k0 + 8 * c) = o; }
    asm volatile("s_waitcnt lgkmcnt(0)" ::: "memory");
}

__device__ __forceinline__ void p0_prologue(const Params& p, LAS unsigned char* lds, int tid, int lane, int wave) {
    unsigned char* ws = p.ws;
    float* mod = (float*)(ws + WS_MOD);
    {
        LAS float* s_lds = (LAS float*)lds; LAS float* red = s_lds + 17 * 1024;
        bool have = false;
        for (int it = blockIdx.x; it < 192; it += gridDim.x) {
            if (!have) {
                for (int i = tid; i < 17 * 1024; i += 512) { const int r = i >> 10, k = i & 1023; const float v = (r < 16) ? p.c[r * 1024 + k] : p.c_ctx[k]; s_lds[i] = v * sigmoidf_(v); }
                have = true;
            }
            __syncthreads();
            const int cl = lane & 31, col = it * 32 + cl, slice = wave * 2 + (lane >> 5);
            float acc[17];
#pragma unroll
            for (int r = 0; r < 17; ++r) acc[r] = 0.f;
#pragma unroll 8
            for (int kk = 0; kk < 64; ++kk) { const int k = slice * 64 + kk; const float wv = p.w_ada[(size_t)k * 6144 + col];
#pragma unroll
                for (int r = 0; r < 17; ++r) acc[r] += s_lds[r * 1024 + k] * wv; }
#pragma unroll
            for (int r = 0; r < 17; ++r) red[(slice * 17 + r) * 32 + cl] = acc[r];
            __syncthreads();
            for (int o = tid; o < 17 * 32; o += 512) { const int r = o >> 5, cc = o & 31; float s = p.b_ada[it * 32 + cc];
#pragma unroll
                for (int sl = 0; sl < 16; ++sl) s += red[(sl * 17 + r) * 32 + cc];
                mod[r * 6144 + it * 32 + cc] = s; }
        }
        __syncthreads();
    }
    bf16* win_t = (bf16*)(ws + WS_WIN); bf16* wuq_t = (bf16*)(ws + WS_WUQ); bf16* wukv_t = (bf16*)(ws + WS_WUKV); bf16* wout_t = (bf16*)(ws + WS_WOUT); bf16* w1_t = (bf16*)(ws + WS_W1); bf16* w2_t = (bf16*)(ws + WS_W2);
    LAS float* scr = (LAS float*)(lds + wave * 8704);
    const int gw = blockIdx.x * 8 + wave, NGW = gridDim.x * 8;
    constexpr int I_IN = 16 * 93, I_UQ = 4 * 24, I_UKV = 2 * 32, I_OUT = 16 * 32, I_1 = 16 * 128, I_2 = 64 * 32, I_ALL = I_IN + I_UQ + I_UKV + I_OUT + I_1 + I_2;
    for (int it = gw; it < I_ALL; it += NGW) {
        int r = it;
        if (r < I_1) { const int kb = r / 128, nb = r % 128; tr_item(p.w_mlp_in, 1024, 4096, w1_t, nb * 32, kb * 64, nb * 32, nullptr, scr, lane); continue; } r -= I_1;
        if (r < I_2) { const int kb = r / 32, nb = r % 32; tr_item(p.w_mlp_out, 4096, 1024, w2_t, nb * 32, kb * 64, nb * 32, nullptr, scr, lane); continue; } r -= I_2;
        if (r < I_IN) { const int kb = r / 93, nb = r % 93, n0 = nb * 32; tr_item(p.w_in, 1024, 2976, win_t, n0 < 416 ? n0 : n0 + 96, kb * 64, n0, nullptr, scr, lane); continue; } r -= I_IN;
        if (r < I_OUT) { const int kb = r / 32, nb = r % 32; tr_item(p.w_out, 1024, 1024, wout_t, nb * 32, kb * 64, nb * 32, nullptr, scr, lane); continue; } r -= I_OUT;
        if (r < I_UQ) { const int kb = r / 24, nb = r % 24; tr_item(p.w_uq, 256, 768, wuq_t, nb * 32, kb * 64, nb * 32, p.q_norm, scr, lane); continue; } r -= I_UQ;
        { const int kb = r / 32, nb = r % 32, hh = nb >> 2, jb = nb & 3; const int dst = (jb < 2) ? hh * 64 + jb * 32 : 512 + hh * 64 + (jb - 2) * 32;
          tr_item(p.w_ukv, 128, 1024, wukv_t, dst, kb * 64, nb * 32, p.kv_norm, scr, lane); }
    }
    { u32x4* z = (u32x4*)(win_t + (size_t)416 * 1024); const int n16 = 96 * 1024 * 2 / 16; for (int i = blockIdx.x * 512 + tid; i < n16; i += gridDim.x * 512) z[i] = (u32x4){0u, 0u, 0u, 0u}; }
}

__device__ __forceinline__ void norm_mod_rows(const float* srcA, int nA, const float* srcB, int nB, const float* __restrict__ gain, const float* __restrict__ mod, int sh_off, int sc_off, bf16* dst, int lane, int wave) {
    const int gw = blockIdx.x * 8 + wave, NGW = gridDim.x * 8, ntot = nA + nB;
    for (int row = gw; row < ntot; row += 2 * NGW) {
        const int row2 = (row + NGW < ntot) ? row + NGW : row;
        const float* s1 = (row < nA) ? srcA + (size_t)row * 1024 : srcB + (size_t)(row - nA) * 1024; const int b1 = (row < nA) ? (row >> 11) : 16;
        const float* s2 = (row2 < nA) ? srcA + (size_t)row2 * 1024 : srcB + (size_t)(row2 - nA) * 1024; const int b2 = (row2 < nA) ? (row2 >> 11) : 16;
        const f32x4* x1 = (const f32x4*)s1 + lane; const f32x4* x2 = (const f32x4*)s2 + lane; f32x4 v[4], u[4]; float sa = 0.f, sb = 0.f;
#pragma unroll
        for (int j = 0; j < 4; ++j) { v[j] = x1[64 * j]; u[j] = x2[64 * j]; }
#pragma unroll
        for (int j = 0; j < 4; ++j) { sa += (v[j].x * v[j].x + v[j].y * v[j].y) + (v[j].z * v[j].z + v[j].w * v[j].w); sb += (u[j].x * u[j].x + u[j].y * u[j].y) + (u[j].z * u[j].z + u[j].w * u[j].w); }
        const float ra = __builtin_amdgcn_rsqf(wave_sum(sa) * (1.f / 1024.f) + EPS), rb = __builtin_amdgcn_rsqf(wave_sum(sb) * (1.f / 1024.f) + EPS);
        const f32x4* gp = (const f32x4*)gain + lane;
        const f32x4* sh1 = (const f32x4*)(mod + b1 * 6144 + sh_off) + lane; const f32x4* sc1 = (const f32x4*)(mod + b1 * 6144 + sc_off) + lane;
        const f32x4* sh2 = (const f32x4*)(mod + b2 * 6144 + sh_off) + lane; const f32x4* sc2 = (const f32x4*)(mod + b2 * 6144 + sc_off) + lane;
        u32x2* o1 = (u32x2*)(dst + (size_t)row * 1024) + lane; u32x2* o2 = (u32x2*)(dst + (size_t)row2 * 1024) + lane;
#pragma unroll
        for (int j = 0; j < 4; ++j) { const f32x4 g = gp[64 * j];
            const f32x4 h1 = (v[j] * ra) * g * (sc1[64 * j] + 1.f) + sh1[64 * j]; u32x2 w1; w1.x = cvtpk(h1.x, h1.y); w1.y = cvtpk(h1.z, h1.w); o1[64 * j] = w1;
            const f32x4 h2 = (u[j] * rb) * g * (sc2[64 * j] + 1.f) + sh2[64 * j]; u32x2 w2; w2.x = cvtpk(h2.x, h2.y); w2.y = cvtpk(h2.z, h2.w); o2[64 * j] = w2; }
    }
}
__device__ __forceinline__ void final_norm_rows(float* buf, int n, const float* __restrict__ gain, int lane, int wave) {
    const int gw = blockIdx.x * 8 + wave, NGW = gridDim.x * 8;
    for (int row = gw; row < n; row += 2 * NGW) {
        const int row2 = (row + NGW < n) ? row + NGW : row;
        f32x4* x1 = (f32x4*)(buf + (size_t)row * 1024) + lane; f32x4* x2 = (f32x4*)(buf + (size_t)row2 * 1024) + lane; f32x4 v[4], u[4]; float sa = 0.f, sb = 0.f;
#pragma unroll
        for (int j = 0; j < 4; ++j) { v[j] = x1[64 * j]; u[j] = x2[64 * j]; }
#pragma unroll
        for (int j = 0; j < 4; ++j) { sa += (v[j].x * v[j].x + v[j].y * v[j].y) + (v[j].z * v[j].z + v[j].w * v[j].w); sb += (u[j].x * u[j].x + u[j].y * u[j].y) + (u[j].z * u[j].z + u[j].w * u[j].w); }
        const float ra = __builtin_amdgcn_rsqf(wave_sum(sa) * (1.f / 1024.f) + EPS), rb = __builtin_amdgcn_rsqf(wave_sum(sb) * (1.f / 1024.f) + EPS);
        const f32x4* gp = (const f32x4*)gain + lane;
#pragma unroll
        for (int j = 0; j < 4; ++j) { const f32x4 g = gp[64 * j]; x1[64 * j] = (v[j] * ra) * g; if (row2 != row) x2[64 * j] = (u[j] * rb) * g; }
    }
}
__device__ __forceinline__ float rope_inv(int j) { return j == 0 ? 1.f : j == 1 ? 0.316227766016838f : j == 2 ? 0.1f : j == 3 ? 0.0316227766016838f : j == 4 ? 0.01f : j == 5 ? 0.00316227766016838f : j == 6 ? 0.001f : 0.000316227766016838f; }
__device__ __forceinline__ void mla_prep_rows(bf16* P, bf16* Kb, int lane, int wave) {
    const int gw = blockIdx.x * 8 + wave, NGW = gridDim.x * 8;
    for (int row = gw; row < MALL; row += NGW) {
        bf16* pr = P + (size_t)row * NP;
        u32x2 q4 = *((u32x2*)(pr + PC_CQ) + lane); unsigned k2 = *((unsigned*)(pr + PC_CKV) + lane);
        unsigned short krv = (lane < 32) ? pr[PC_KR + lane] : (unsigned short)0;
        float a0 = blo(q4.x), a1 = bhi(q4.x), a2 = blo(q4.y), a3 = bhi(q4.y);
        const float rq = __builtin_amdgcn_rsqf(wave_sum((a0 * a0 + a1 * a1) + (a2 * a2 + a3 * a3)) * (1.f / 256.f) + EPS);
        float c0 = blo(k2), c1 = bhi(k2);
        const float rk = __builtin_amdgcn_rsqf(wave_sum(c0 * c0 + c1 * c1) * (1.f / 128.f) + EPS);
        u32x2 qo; qo.x = cvtpk(a0 * rq, a1 * rq); qo.y = cvtpk(a2 * rq, a3 * rq);
        *((u32x2*)(pr + PC_CQ) + lane) = qo; *((unsigned*)(pr + PC_CKV) + lane) = cvtpk(c0 * rk, c1 * rk);
        float v = b2f(krv); const float vp = __shfl_xor(v, 8);
        if (row < NLAT) { const int t = row & 2047, j = lane & 31; const int pos = (j & 16) ? (t & 63) : (t >> 6);
            const int fi = j & 7; const float inv = __builtin_amdgcn_exp2f(-(float)fi * 1.660964047443681f);
            const float ang = (float)pos * inv; const float cs = __cosf(ang), sn = __sinf(ang);
            v = (j & 8) ? (v * cs + vp * sn) : (v * cs - vp * sn); }
        if (lane < 32) { const bf16 o = f2b(v); bf16* kp = Kb + (size_t)row * 768 + 64 + lane;
#pragma unroll
            for (int h = 0; h < 8; ++h) kp[h * 96] = o; }
    }
}
__device__ __forceinline__ void hg_finalize_rows(const bf16* Of, const bf16* Ob, const bf16* P, const float* __restrict__ hgn, bf16* MIX, int lane, int wave) {
    const int gw = blockIdx.x * 8 + wave, NGW = gridDim.x * 8;
    f32x4 g0 = *(const f32x4*)(hgn + (lane & 15) * 8), g1 = *(const f32x4*)(hgn + (lane & 15) * 8 + 4);
    for (int row = gw; row < NLAT; row += NGW) {
        const u32x4 a = *((const u32x4*)(Of + (size_t)row * 512) + lane), b = *((const u32x4*)(Ob + (size_t)row * 512) + lane), g = *((const u32x4*)(P + (size_t)row * NP + PC_HG) + lane);
        float o[8]; o[0] = blo(a.x) + blo(b.x); o[1] = bhi(a.x) + bhi(b.x); o[2] = blo(a.y) + blo(b.y); o[3] = bhi(a.y) + bhi(b.y); o[4] = blo(a.z) + blo(b.z); o[5] = bhi(a.z) + bhi(b.z); o[6] = blo(a.w) + blo(b.w); o[7] = bhi(a.w) + bhi(b.w);
        float gz[8]; gz[0] = blo(g.x); gz[1] = bhi(g.x); gz[2] = blo(g.y); gz[3] = bhi(g.y); gz[4] = blo(g.z); gz[5] = bhi(g.z); gz[6] = blo(g.w); gz[7] = bhi(g.w);
        float s = 0.f;
#pragma unroll
        for (int j = 0; j < 8; ++j) s += o[j] * o[j];
        s += __shfl_xor(s, 1); s += __shfl_xor(s, 2); s += __shfl_xor(s, 4); s += __shfl_xor(s, 8);
        const float rs = __builtin_amdgcn_rsqf(s * (1.f / 128.f) + EPS);
        const float gn[8] = {g0.x, g0.y, g0.z, g0.w, g1.x, g1.y, g1.z, g1.w};
        float r[8];
#pragma unroll
        for (int j = 0; j < 8; ++j) r[j] = o[j] * rs * gn[j] * (gz[j] * sigmoidf_(gz[j]));
        u32x4 w; w.x = cvtpk(r[0], r[1]); w.y = cvtpk(r[2], r[3]); w.z = cvtpk(r[4], r[5]); w.w = cvtpk(r[6], r[7]);
        *((u32x4*)(MIX + (size_t)row * 1024 + 512) + lane) = w;
    }
}
constexpr int AT_KSTR = 208, AT_VSTR = 272, AT_KBYTES = 128 * AT_KSTR, AT_BUF = AT_KBYTES + 64 * AT_VSTR;
__device__ __forceinline__ void attn_unit(int b, int h, int qb, const bf16* __restrict__ Q, const bf16* __restrict__ Kb, const bf16* __restrict__ Vt, bf16* MIX, LAS unsigned char* lds, int tid, int lane, int wid) {
    const int r32 = lane & 31, hi = lane >> 5;
    const int tpos = qb * 256 + wid * 32 + r32; const size_t qrow = (size_t)b * 2048 + tpos;
    const bf16* Qp = Q + qrow * 768 + h * 96;
    bf16x8 qr[6];
#pragma unroll
    for (int d0 = 0; d0 < 4; ++d0) qr[d0] = *(const bf16x8*)(Qp + d0 * 16 + hi * 8);
#pragma unroll
    for (int hf = 0; hf < 2; ++hf) {
        const u32x4 x1 = *(const u32x4*)(Qp + 64 + hf * 16), x2 = *(const u32x4*)(Qp + 64 + hf * 16 + 8);
        const float pos = (float)(hf ? (tpos & 63) : (tpos >> 6));
        float o[8];
#pragma unroll
        for (int j = 0; j < 8; ++j) { const unsigned w1 = x1[j >> 1], w2 = x2[j >> 1]; const float a = (j & 1) ? bhi(w1) : blo(w1), bb = (j & 1) ? bhi(w2) : blo(w2);
            const float ang = pos * rope_inv(j); const float cs = __cosf(ang), sn = __sinf(ang);
            o[j] = hi ? (bb * cs + a * sn) : (a * cs - bb * sn); }
        u32x4 w; w.x = cvtpk(o[0], o[1]); w.y = cvtpk(o[2], o[3]); w.z = cvtpk(o[4], o[5]); w.w = cvtpk(o[6], o[7]);
        qr[4 + hf] = __builtin_bit_cast(bf16x8, w);
    }
    int kkey[3], kpart[3];
#pragma unroll
    for (int i = 0; i < 3; ++i) { const int ci = tid + 512 * i; kkey[i] = ci / 12; kpart[i] = ci % 12; }
    const int vd = tid >> 4, vc = tid & 15;
    const bf16* Vsrc = Vt + ((size_t)((b * 8 + h) * 64 + vd)) * NKEY + vc * 8;
    u32x4 kreg[3], vreg[2];
#define AT_LOAD(kt) do { const size_t krow0 = ((kt) < 16) ? (size_t)b * 2048 + (kt) * 128 : (size_t)NLAT + b * 256 + ((kt) - 16) * 128; \
        _Pragma("unroll") for (int i = 0; i < 3; ++i) kreg[i] = *(const u32x4*)(Kb + (krow0 + kkey[i]) * 768 + h * 96 + kpart[i] * 8); \
        vreg[0] = *(const u32x4*)(Vsrc + (kt) * 128); vreg[1] = *(const u32x4*)(Vsrc + (size_t)32 * NKEY + (kt) * 128); } while (0)
#define AT_STORE(bufo) do { _Pragma("unroll") for (int i = 0; i < 3; ++i) *(LAS u32x4*)(lds + (bufo) + kkey[i] * AT_KSTR + kpart[i] * 16) = kreg[i]; \
        *(LAS u32x4*)(lds + (bufo) + AT_KBYTES + vd * AT_VSTR + vc * 16) = vreg[0]; *(LAS u32x4*)(lds + (bufo) + AT_KBYTES + (32 + vd) * AT_VSTR + vc * 16) = vreg[1]; } while (0)
    AT_LOAD(0); AT_STORE(0);
    LDS_BARRIER();
    float m_run = 0.f, l_run = 0.f; f32x16 o0 = {}, o1 = {}, negm = {};
    constexpr int NT = NKEY / 128;
    for (int kt = 0; kt < NT; ++kt) {
        const int bufo = (kt & 1) * AT_BUF;
        if (kt + 1 < NT) AT_LOAD(kt + 1);
        f32x16 pa0, pa1, pc0, pc1;
        {
            const LAS unsigned char* kb = lds + bufo + r32 * AT_KSTR + hi * 16;
            { const bf16x8 a0 = *(const LAS bf16x8*)(kb), a1 = *(const LAS bf16x8*)(kb + 32 * AT_KSTR), a2 = *(const LAS bf16x8*)(kb + 64 * AT_KSTR), a3 = *(const LAS bf16x8*)(kb + 96 * AT_KSTR);
              pa0 = __builtin_amdgcn_mfma_f32_32x32x16_bf16(a0, qr[0], negm, 0, 0, 0); pa1 = __builtin_amdgcn_mfma_f32_32x32x16_bf16(a1, qr[0], negm, 0, 0, 0);
              pc0 = __builtin_amdgcn_mfma_f32_32x32x16_bf16(a2, qr[0], negm, 0, 0, 0); pc1 = __builtin_amdgcn_mfma_f32_32x32x16_bf16(a3, qr[0], negm, 0, 0, 0); }
#pragma unroll
            for (int d0 = 1; d0 < 6; ++d0) {
                const bf16x8 a0 = *(const LAS bf16x8*)(kb + d0 * 32), a1 = *(const LAS bf16x8*)(kb + 32 * AT_KSTR + d0 * 32), a2 = *(const LAS bf16x8*)(kb + 64 * AT_KSTR + d0 * 32), a3 = *(const LAS bf16x8*)(kb + 96 * AT_KSTR + d0 * 32);
                pa0 = __builtin_amdgcn_mfma_f32_32x32x16_bf16(a0, qr[d0], pa0, 0, 0, 0); pa1 = __builtin_amdgcn_mfma_f32_32x32x16_bf16(a1, qr[d0], pa1, 0, 0, 0);
                pc0 = __builtin_amdgcn_mfma_f32_32x32x16_bf16(a2, qr[d0], pc0, 0, 0, 0); pc1 = __builtin_amdgcn_mfma_f32_32x32x16_bf16(a3, qr[d0], pc1, 0, 0, 0);
            }
        }
        float mt = fmaxf(fmaxf(pa0[0], pa1[0]), fmaxf(pc0[0], pc1[0]));
#pragma unroll
        for (int r = 1; r < 16; ++r) mt = fmaxf(mt, fmaxf(fmaxf(pa0[r], pa1[r]), fmaxf(pc0[r], pc1[r])));
        mt = fmaxf(mt, __shfl_xor(mt, 32));
        const bool first = (kt == 0);
        if (first || __any(mt > 8.f)) {
            const float delta = first ? mt : fmaxf(mt, 0.f); const float alpha = first ? 1.f : __builtin_amdgcn_exp2f(-delta);
            m_run += delta; l_run *= alpha;
#pragma unroll
            for (int r = 0; r < 16; ++r) { pa0[r] -= delta; pa1[r] -= delta; pc0[r] -= delta; pc1[r] -= delta; o0[r] *= alpha; o1[r] *= alpha; negm[r] = -m_run; }
        }
#define AT_HALF(P0, P1, sub) do { float ls0 = 0.f, ls1 = 0.f; \
            _Pragma("unroll") for (int r = 0; r < 16; ++r) { P0[r] = __builtin_amdgcn_exp2f(P0[r]); P1[r] = __builtin_amdgcn_exp2f(P1[r]); ls0 += P0[r]; ls1 += P1[r]; } \
            l_run += ls0 + ls1; \
            bf16x8 pb[2][2]; \
            _Pragma("unroll") for (int s = 0; s < 2; ++s) { \
                u32x4 w; w.x = cvtpk(P0[8 * s + 0], P0[8 * s + 1]); w.y = cvtpk(P0[8 * s + 2], P0[8 * s + 3]); w.z = cvtpk(P0[8 * s + 4], P0[8 * s + 5]); w.w = cvtpk(P0[8 * s + 6], P0[8 * s + 7]); pb[0][s] = __builtin_bit_cast(bf16x8, w); \
                u32x4 y; y.x = cvtpk(P1[8 * s + 0], P1[8 * s + 1]); y.y = cvtpk(P1[8 * s + 2], P1[8 * s + 3]); y.z = cvtpk(P1[8 * s + 4], P1[8 * s + 5]); y.w = cvtpk(P1[8 * s + 6], P1[8 * s + 7]); pb[1][s] = __builtin_bit_cast(bf16x8, y); } \
            const LAS unsigned char* vb = lds + bufo + AT_KBYTES + r32 * AT_VSTR + (sub) * 128 + hi * 16; \
            _Pragma("unroll") for (int X = 0; X < 2; ++X) _Pragma("unroll") for (int s = 0; s < 2; ++s) { const int ko = (32 * X + 16 * s) * 2; \
                const bf16x8 a0 = *(const LAS bf16x8*)(vb + ko), a1 = *(const LAS bf16x8*)(vb + 32 * AT_VSTR + ko); \
                o0 = __builtin_amdgcn_mfma_f32_32x32x16_bf16(a0, pb[X][s], o0, 0, 0, 0); o1 = __builtin_amdgcn_mfma_f32_32x32x16_bf16(a1, pb[X][s], o1, 0, 0, 0); } } while (0)
        AT_HALF(pa0, pa1, 0);
        AT_HALF(pc0, pc1, 1);
#undef AT_HALF
        if (kt + 1 < NT) AT_STORE(((kt + 1) & 1) * AT_BUF);
        LDS_BARRIER();
    }
#undef AT_LOAD
#undef AT_STORE
    const float linv = __builtin_amdgcn_rcpf(l_run + __shfl_xor(l_run, 32));
    bf16* Op = MIX + qrow * 1024 + h * 64 + 4 * hi;
#pragma unroll
    for (int g = 0; g < 4; ++g) {
        u32x2 w0; w0.x = cvtpk(o0[4 * g] * linv, o0[4 * g + 1] * linv); w0.y = cvtpk(o0[4 * g + 2] * linv, o0[4 * g + 3] * linv); *(u32x2*)(Op + 8 * g) = w0;
        u32x2 w1; w1.x = cvtpk(o1[4 * g] * linv, o1[4 * g + 1] * linv); w1.y = cvtpk(o1[4 * g + 2] * linv, o1[4 * g + 3] * linv); *(u32x2*)(Op + 32 + 8 * g) = w1;
    }
}

constexpr int HG_QT = 0, HG_KT = 17408, HG_QH = 34816, HG_KHT = 52224, HG_VT = 70656, HG_AM = 89088, HG_ST = 98304, HG_DK = 133120, HG_PART = 133632;
__device__ __forceinline__ void hgrn_unit(int u, const bf16* __restrict__ P, bf16* Of, bf16* Ob, LAS unsigned char* lds, int tid, int lane, int wid) {
    const int dir = u & 1, h = (u >> 1) & 3, b = u >> 3;
    const int r32 = lane & 31, hi = lane >> 5;
    const int k0 = 2 * lane, tq = wid;
    const int qcol = PC_HQ + h * 128 + k0, zcol = (dir ? PC_HB : PC_HF) + h * 128 + k0, vcol = PC_HI + h * 128;
    const int vs = tid >> 4, vc16 = tid & 15;
    bf16* Od = dir ? Ob : Of;
    LAS bf16* Qt = (LAS bf16*)(lds + HG_QT); LAS bf16* Kt = (LAS bf16*)(lds + HG_KT); LAS bf16* Qh = (LAS bf16*)(lds + HG_QH); LAS bf16* KhT = (LAS bf16*)(lds + HG_KHT);
    LAS bf16* Vl = (LAS bf16*)(lds + HG_VT); LAS bf16* Am = (LAS bf16*)(lds + HG_AM); LAS bf16* St = (LAS bf16*)(lds + HG_ST); LAS float* dk = (LAS float*)(lds + HG_DK); LAS float* part = (LAS float*)(lds + HG_PART);
    f32x16 S0 = {}, S1 = {};
    for (int i = tid; i < 128 * 136 / 2; i += 512) ((LAS unsigned*)St)[i] = 0u;
    unsigned qv[8], zv[8]; u32x4 vv0, vv1;
#define HG_ROW0(ci) ((dir == 0) ? (((ci) < 4) ? (size_t)NLAT + b * 256 + (ci) * 64 : (size_t)b * 2048 + ((ci) - 4) * 64) : (((ci) < 4) ? (size_t)NLAT + b * 256 + (3 - (ci)) * 64 : (size_t)b * 2048 + (35 - (ci)) * 64))
#define HG_LOAD(ci) do { const bf16* pb_ = P + (HG_ROW0(ci) + 8 * tq) * NP; \
        _Pragma("unroll") for (int j = 0; j < 8; ++j) { qv[j] = *(const unsigned*)(pb_ + (size_t)j * NP + qcol); zv[j] = *(const unsigned*)(pb_ + (size_t)j * NP + zcol); } \
        vv0 = *(const u32x4*)(P + (HG_ROW0(ci) + vs) * NP + vcol + vc16 * 8); vv1 = *(const u32x4*)(P + (HG_ROW0(ci) + 32 + vs) * NP + vcol + vc16 * 8); } while (0)
#define HG_VPUT(vv, s_) do { Vl[(8 * vc16 + 0) * 72 + (s_)] = (bf16)((vv).x & 0xffffu); Vl[(8 * vc16 + 1) * 72 + (s_)] = (bf16)((vv).x >> 16); Vl[(8 * vc16 + 2) * 72 + (s_)] = (bf16)((vv).y & 0xffffu); Vl[(8 * vc16 + 3) * 72 + (s_)] = (bf16)((vv).y >> 16); \
        Vl[(8 * vc16 + 4) * 72 + (s_)] = (bf16)((vv).z & 0xffffu); Vl[(8 * vc16 + 5) * 72 + (s_)] = (bf16)((vv).z >> 16); Vl[(8 * vc16 + 6) * 72 + (s_)] = (bf16)((vv).w & 0xffffu); Vl[(8 * vc16 + 7) * 72 + (s_)] = (bf16)((vv).w >> 16); } while (0)
    HG_LOAD(0);
    for (int ci = 0; ci < 36; ++ci) {
        const size_t row0 = HG_ROW0(ci);
        float c0[8], c1[8], kk0[8], kk1[8], q0[8], q1[8];
#pragma unroll
        for (int j = 0; j < 8; ++j) { c0[j] = blo(zv[j]); c1[j] = bhi(zv[j]); kk0[j] = 1.f - __expf(c0[j]); kk1[j] = 1.f - __expf(c1[j]); q0[j] = blo(qv[j]); q1[j] = bhi(qv[j]); }
        if (dir == 0) {
#pragma unroll
            for (int j = 1; j < 8; ++j) { c0[j] += c0[j - 1]; c1[j] += c1[j - 1]; }
            *(LAS f32x2_t*)(part + tq * 128 + k0) = (f32x2_t){c0[7], c1[7]};
        } else {
#pragma unroll
            for (int j = 6; j >= 0; --j) { c0[j] += c0[j + 1]; c1[j] += c1[j + 1]; }
            *(LAS f32x2_t*)(part + tq * 128 + k0) = (f32x2_t){c0[0], c1[0]};
        }
        LDS_BARRIER();
        {
            float tot0 = 0.f, tot1 = 0.f, off0 = 0.f, off1 = 0.f, ref0 = 0.f, ref1 = 0.f;
#pragma unroll
            for (int i = 0; i < 8; ++i) { const f32x2_t pp = *(const LAS f32x2_t*)(part + i * 128 + k0); tot0 += pp.x; tot1 += pp.y;
                const bool before = dir ? (i > tq) : (i < tq); const bool inref = dir ? (i >= 4) : (i < 4);
                off0 += before ? pp.x : 0.f; off1 += before ? pp.y : 0.f; ref0 += inref ? pp.x : 0.f; ref1 += inref ? pp.y : 0.f; }
            const float eref0 = __expf(ref0), eref1 = __expf(ref1), etr0 = __expf(tot0 - ref0), etr1 = __expf(tot1 - ref1);
            off0 -= ref0; off1 -= ref1;
            float kh0[8], kh1[8];
#pragma unroll
            for (int j = 0; j < 8; ++j) { const float E0 = __expf(off0 + c0[j]), E1 = __expf(off1 + c1[j]); const float qt0 = q0[j] * E0, qt1 = q1[j] * E1, kt0 = kk0[j] * __builtin_amdgcn_rcpf(E0), kt1 = kk1[j] * __builtin_amdgcn_rcpf(E1);
                const int t = 8 * tq + j;
                *(LAS unsigned*)(Qt + t * 136 + k0) = cvtpk(qt0, qt1); *(LAS unsigned*)(Kt + t * 136 + k0) = cvtpk(kt0, kt1); *(LAS unsigned*)(Qh + t * 136 + k0) = cvtpk(qt0 * eref0, qt1 * eref1);
                kh0[j] = kt0 * etr0; kh1[j] = kt1 * etr1; }
            u32x4 w0, w1; w0.x = cvtpk(kh0[0], kh0[1]); w0.y = cvtpk(kh0[2], kh0[3]); w0.z = cvtpk(kh0[4], kh0[5]); w0.w = cvtpk(kh0[6], kh0[7]); w1.x = cvtpk(kh1[0], kh1[1]); w1.y = cvtpk(kh1[2], kh1[3]); w1.z = cvtpk(kh1[4], kh1[5]); w1.w = cvtpk(kh1[6], kh1[7]);
            *(LAS u32x4*)(KhT + k0 * 72 + 8 * tq) = w0; *(LAS u32x4*)(KhT + (k0 + 1) * 72 + 8 * tq) = w1;
            if (tq == 0) *(LAS f32x2_t*)(dk + k0) = (f32x2_t){__expf(tot0), __expf(tot1)};
            HG_VPUT(vv0, vs); HG_VPUT(vv1, 32 + vs);
        }
        if (ci + 1 < 36) HG_LOAD(ci + 1);
        LDS_BARRIER();
        if (wid < 4) {
            const int ti = wid >> 1, cj = wid & 1;
            f32x16 a = {};
            const LAS bf16* ap = Kt + (32 * cj + r32) * 136 + 8 * hi; const LAS bf16* bp = Qt + (32 * ti + r32) * 136 + 8 * hi;
#pragma unroll
            for (int ks = 0; ks < 8; ++ks) a = __builtin_amdgcn_mfma_f32_32x32x16_bf16(*(const LAS bf16x8*)(ap + 16 * ks), *(const LAS bf16x8*)(bp + 16 * ks), a, 0, 0, 0);
            const int t_ = 32 * ti + r32;
#pragma unroll
            for (int g = 0; g < 4; ++g) { float v[4];
#pragma unroll
                for (int e = 0; e < 4; ++e) { const int s_ = 32 * cj + 8 * g + 4 * hi + e; const bool keep = dir ? (s_ >= t_) : (s_ <= t_); v[e] = keep ? a[4 * g + e] : 0.f; }
                u32x2 w; w.x = cvtpk(v[0], v[1]); w.y = cvtpk(v[2], v[3]); *(LAS u32x2*)(Am + t_ * 72 + 32 * cj + 8 * g + 4 * hi) = w; }
        }
        const int oi = wid >> 2, nj = wid & 3;
        f32x16 oacc = {};
        {
            const LAS bf16* ap = St + (32 * nj + r32) * 136 + 8 * hi; const LAS bf16* bp = Qh + (32 * oi + r32) * 136 + 8 * hi;
#pragma unroll
            for (int ks = 0; ks < 8; ++ks) oacc = __builtin_amdgcn_mfma_f32_32x32x16_bf16(*(const LAS bf16x8*)(ap + 16 * ks), *(const LAS bf16x8*)(bp + 16 * ks), oacc, 0, 0, 0);
        }
        LDS_BARRIER();
        {
            const LAS bf16* ap = Vl + (32 * nj + r32) * 72 + 8 * hi; const LAS bf16* bp = Am + (32 * oi + r32) * 72 + 8 * hi;
#pragma unroll
            for (int ks = 0; ks < 4; ++ks) oacc = __builtin_amdgcn_mfma_f32_32x32x16_bf16(*(const LAS bf16x8*)(ap + 16 * ks), *(const LAS bf16x8*)(bp + 16 * ks), oacc, 0, 0, 0);
            if (ci >= 4) { bf16* op = Od + (row0 + 32 * oi + r32) * 512 + h * 128 + 32 * nj + 4 * hi;
#pragma unroll
                for (int g = 0; g < 4; ++g) { u32x2 w; w.x = cvtpk(oacc[4 * g], oacc[4 * g + 1]); w.y = cvtpk(oacc[4 * g + 2], oacc[4 * g + 3]); *(u32x2*)(op + 8 * g) = w; } }
        }
        {
            const int si = wid >> 1, sj0 = 2 * (wid & 1);
#pragma unroll
            for (int r = 0; r < 16; ++r) { const float d = dk[32 * si + (r & 3) + 8 * (r >> 2) + 4 * hi]; S0[r] *= d; S1[r] *= d; }
            const LAS bf16* ap = KhT + (32 * si + r32) * 72 + 8 * hi; const LAS bf16* bp0 = Vl + (32 * sj0 + r32) * 72 + 8 * hi; const LAS bf16* bp1 = bp0 + 32 * 72;
#pragma unroll
            for (int ks = 0; ks < 4; ++ks) { const bf16x8 av = *(const LAS bf16x8*)(ap + 16 * ks);
                S0 = __builtin_amdgcn_mfma_f32_32x32x16_bf16(av, *(const LAS bf16x8*)(bp0 + 16 * ks), S0, 0, 0, 0); S1 = __builtin_amdgcn_mfma_f32_32x32x16_bf16(av, *(const LAS bf16x8*)(bp1 + 16 * ks), S1, 0, 0, 0); }
            LAS bf16* sp0 = St + (32 * sj0 + r32) * 136 + 32 * si + 4 * hi; LAS bf16* sp1 = sp0 + 32 * 136;
#pragma unroll
            for (int g = 0; g < 4; ++g) { u32x2 w; w.x = cvtpk(S0[4 * g], S0[4 * g + 1]); w.y = cvtpk(S0[4 * g + 2], S0[4 * g + 3]); *(LAS u32x2*)(sp0 + 8 * g) = w;
                u32x2 y; y.x = cvtpk(S1[4 * g], S1[4 * g + 1]); y.y = cvtpk(S1[4 * g + 2], S1[4 * g + 3]); *(LAS u32x2*)(sp1 + 8 * g) = y; }
        }
        LDS_BARRIER();
    }
#undef HG_LOAD
#undef HG_ROW0
#undef HG_VPUT
}
#define XB_TMO      128
#define XB_XCNT(j)  (256  + 64 * (j))
#define XB_XSUB(j)  (1280 + 64 * (j))
#define XB_XGEN(j)  (2304 + 64 * (j))
#define XB_TOP      3328
#define XB_TOPGEN   3392
#define XCD_BAR_WORDS 3456
#define XB_SPIN_CAP (1u << 18)

__device__ __forceinline__ unsigned xb_ld(unsigned* p)              { return __hip_atomic_load(p, __ATOMIC_RELAXED, __HIP_MEMORY_SCOPE_AGENT); }
__device__ __forceinline__ unsigned xb_add(unsigned* p, unsigned v) { return __hip_atomic_fetch_add(p, v, __ATOMIC_RELAXED, __HIP_MEMORY_SCOPE_AGENT); }
__device__ __forceinline__ unsigned xb_xcc_id() { return (unsigned)__builtin_amdgcn_s_getreg((3 << 11) | 20) & 0xFu; }
#define XB_SPIN(cond, bar) do { unsigned _sp = 0; while (cond) { __builtin_amdgcn_s_sleep(1); \
    if ((++_sp & 255u) == 0u) { if (xb_ld(&(bar)[XB_TMO])) break; if (_sp > XB_SPIN_CAP) { atomicAdd(&(bar)[XB_TMO], 1u); break; } } } } while (0)

struct XcdBarrier {
    unsigned* bar; unsigned x;
    volatile LAS unsigned* st;
};

__device__ __forceinline__ XcdBarrier xcd_barrier_post(unsigned* bar, volatile LAS unsigned* st, int tid) {
    XcdBarrier b; b.bar = bar; b.x = xb_xcc_id(); b.st = st;
    if (tid == 0) (void)xb_add(&bar[XB_XCNT(b.x)], 1u);
    return b;
}
__device__ __forceinline__ void xcd_barrier_complete(unsigned* bar, unsigned x, unsigned& nloc, unsigned& nx) {
    const unsigned G = gridDim.x * gridDim.y * gridDim.z;
    unsigned sum, cnt, mine, sp = 0u;
    for (;;) {
        sum = 0u; cnt = 0u; mine = 0u;
#pragma unroll
        for (unsigned j = 0; j < 16; ++j) { const unsigned c = xb_ld(&bar[XB_XCNT(j)]); sum += c; cnt += (c > 0u) ? 1u : 0u; mine = (j == x) ? c : mine; }
        if (sum == G) break;
        __builtin_amdgcn_s_sleep(1);
        if ((++sp & 255u) == 0u) { if (xb_ld(&bar[XB_TMO])) break; if (sp > XB_SPIN_CAP) { atomicAdd(&bar[XB_TMO], 1u); break; } }
    }
    nloc = mine > 0u ? mine : 1u; nx = cnt > 0u ? cnt : 1u;
}

__device__ __forceinline__ void xcd_barrier(const XcdBarrier& b, int tid) {
    asm volatile("s_waitcnt vmcnt(0)" ::: "memory");
    __syncthreads();
    if (tid == 0) {
        unsigned* bar = b.bar;
        __builtin_amdgcn_s_waitcnt(0);
        unsigned nloc = b.st[0], nx = b.st[1];
        if (nloc == 0u) { xcd_barrier_complete(bar, b.x, nloc, nx); b.st[0] = nloc; b.st[1] = nx; }
        const unsigned old = xb_add(&bar[XB_XSUB(b.x)], 1u);
        const unsigned gen = old / nloc;
        if (old + 1u == (gen + 1u) * nloc) {
            __builtin_amdgcn_fence(__ATOMIC_RELEASE, "agent");
            asm volatile("s_waitcnt vmcnt(0)" ::: "memory");
            const unsigned og = xb_add(&bar[XB_TOP], 1u);
            const unsigned tg = og / nx;
            if (og + 1u == (tg + 1u) * nx) xb_add(&bar[XB_TOPGEN], 1u);
            else XB_SPIN(xb_ld(&bar[XB_TOPGEN]) == tg, bar);
            __builtin_amdgcn_fence(__ATOMIC_ACQUIRE, "agent");
            xb_add(&bar[XB_XGEN(b.x)], 1u);
            asm volatile("s_waitcnt vmcnt(0)" ::: "memory");
        } else {
            XB_SPIN(xb_ld(&bar[XB_XGEN(b.x)]) == gen, bar);
            __builtin_amdgcn_fence(__ATOMIC_ACQUIRE, "agent");
            asm volatile("s_waitcnt vmcnt(0)" ::: "memory");
        }
    }
    __syncthreads();
}

__global__ void __launch_bounds__(512) hymba_fwd(Params p) {
    extern __shared__ __attribute__((aligned(16))) unsigned char lds_raw[];
    LAS unsigned char* lds = (LAS unsigned char*)lds_raw;
    if (p.coop) { cg::grid_group grid = cg::this_grid(); grid.sync(); }
    const int G = gridDim.x; const int wave_s = __builtin_amdgcn_readfirstlane((int)threadIdx.x >> 6);
#define VCU() ((G % 8 == 0) ? ((int)blockIdx.x % 8) * (G / 8) + (int)blockIdx.x / 8 : (int)blockIdx.x)
#define TIDS() const int wave = wave_s, lane = lane_id_opaque(), tid = wave * 64 + lane
#define WSP(T, off) ((T*)(p.ws + (off)))
    const int lo = p.ph_lo, hi = p.ph_hi;
    unsigned xcc_s;
    { TIDS(); if (tid == 0) { ((volatile LAS unsigned*)(lds + LDS_BYTES - 64))[0] = 0u; ((volatile LAS unsigned*)(lds + LDS_BYTES - 64))[1] = 0u; }
      const XcdBarrier b0 = xcd_barrier_post((unsigned*)p.ws, (volatile LAS unsigned*)(lds + LDS_BYTES - 64), tid); xcc_s = b0.x; }
#define IN(k) (lo <= (k) && (k) < hi)
#define REPEAT(k) _Pragma("unroll") for (int rep__ = 0; rep__ < (((REP_MASK) >> (k)) & 1) + 1; ++rep__)
#define SEAM(k) do { if (IN(k) && IN((k) + 1)) { TIDS(); XcdBarrier bar_; bar_.bar = (unsigned*)p.ws; bar_.x = xcc_s; bar_.st = (volatile LAS unsigned*)(lds + LDS_BYTES - 64); xcd_barrier(bar_, tid); } } while (0)
    if (IN(0)) REPEAT(0) { TIDS(); p0_prologue(p, lds, tid, lane, wave); }
    SEAM(0);
    if (IN(1)) REPEAT(1) { TIDS(); norm_mod_rows(p.x, NLAT, p.ctx, NCTXR, p.norm_mix, WSP(float, WS_MOD), 0, 1024, WSP(bf16, WS_XN), lane, wave); }
    SEAM(1);
    if (IN(2)) REPEAT(2) { pg8::Gemm g{WSP(bf16, WS_XN), 1024, WSP(bf16, WS_WIN), MALL, NP, 1024}; pg8::StaticOrder S; S.init(MALL, NP, G, (int)blockIdx.x);
        pg8::EpiIn E{WSP(bf16, WS_P), p.hgrn_lb}; pg8::gemm_phase<pg8::EpiIn, pg8::StaticOrder, true, true>(lds, g, S, E, wave_s); }
    SEAM(2);
    if (IN(3)) { TIDS(); mla_prep_rows(WSP(bf16, WS_P), WSP(bf16, WS_K), lane, wave); }
    SEAM(3);
    if (IN(4)) REPEAT(4) {
        { pg8::Gemm g{WSP(bf16, WS_P) + PC_CQ, NP, WSP(bf16, WS_WUQ), NLAT, 768, 256}; pg8::StaticOrder S; S.init(NLAT, 768, G, (int)blockIdx.x);
          pg8::EpiBf16<0> E{WSP(bf16, WS_Q), 768, nullptr, 768, 0, QSCALE}; pg8::gemm_phase<pg8::EpiBf16<0>, pg8::StaticOrder, true, true>(lds, g, S, E, wave_s); }
        { pg8::Gemm g{WSP(bf16, WS_P) + PC_CKV, NP, WSP(bf16, WS_WUKV), MALL, 1024, 128}; pg8::StaticOrder S; S.init(MALL, 1024, G, (int)blockIdx.x);
          pg8::EpiKV E{WSP(bf16, WS_K), WSP(bf16, WS_VT)}; pg8::gemm_phase<pg8::EpiKV, pg8::StaticOrder, true, true>(lds, g, S, E, wave_s); }
    }
    SEAM(4);
    if (IN(5)) {
        { TIDS(); if ((((int)blockIdx.x >> 3) & 1) == 0) for (int u = ((int)blockIdx.x & 7) * (G >> 4) + ((int)blockIdx.x >> 4); u < 128; u += (G >> 1)) hgrn_unit(u, WSP(bf16, WS_P), (bf16*)p.out, (bf16*)p.out + (size_t)NLAT * 512, lds, tid, lane, wave); }
        { TIDS(); volatile LAS unsigned* slot = (volatile LAS unsigned*)(lds + LDS_BYTES - 128);
          for (;;) {
              if (tid == 0) slot[0] = __hip_atomic_fetch_add((unsigned*)p.ws + 3584, 1u, __ATOMIC_RELAXED, __HIP_MEMORY_SCOPE_AGENT);
              __syncthreads(); const int u = (int)slot[0]; __syncthreads();
              if (u >= 1024) break;
              attn_unit(u >> 6, (u >> 3) & 7, u & 7, WSP(bf16, WS_Q), WSP(bf16, WS_K), WSP(bf16, WS_VT), WSP(bf16, WS_XN), lds, tid, lane, wave);
          } }
    }
    SEAM(5);
    if (IN(6)) REPEAT(6) { TIDS(); hg_finalize_rows((bf16*)p.out, (bf16*)p.out + (size_t)NLAT * 512, WSP(bf16, WS_P), p.hgrn_norm, WSP(bf16, WS_XN), lane, wave); }
    SEAM(6);
    if (IN(7)) REPEAT(7) { pg8::Gemm g{WSP(bf16, WS_XN), 1024, WSP(bf16, WS_WOUT), NLAT, 1024, 1024}; pg8::StaticOrder S; S.init(NLAT, 1024, G, (int)blockIdx.x);
        pg8::EpiRes E{p.x, p.out, WSP(float, WS_MOD) + 2048}; pg8::gemm_phase<pg8::EpiRes, pg8::StaticOrder, true, true>(lds, g, S, E, wave_s); }
    SEAM(7);
    if (IN(8)) REPEAT(8) { TIDS(); norm_mod_rows(p.out, NLAT, p.out, 0, p.norm_mlp, WSP(float, WS_MOD), 3072, 4096, WSP(bf16, WS_XN), lane, wave); }
    SEAM(8);
    if (IN(9)) REPEAT(9) { pg8::Gemm g{WSP(bf16, WS_XN), 1024, WSP(bf16, WS_W1), NLAT, DFF, 1024}; pg8::StaticOrder S; S.init(NLAT, DFF, G, (int)blockIdx.x);
        pg8::EpiRelu2 E{WSP(bf16, WS_HID), DFF}; pg8::gemm_phase<pg8::EpiRelu2, pg8::StaticOrder, true, true>(lds, g, S, E, wave_s); }
    SEAM(9);
    if (IN(10)) { pg8::Gemm g{WSP(bf16, WS_HID), DFF, WSP(bf16, WS_W2), NLAT, 1024, DFF}; pg8::StaticOrder S; S.init(NLAT, 1024, G, (int)blockIdx.x);
        pg8::EpiRes E{p.out, p.out, WSP(float, WS_MOD) + 5120}; pg8::gemm_phase<pg8::EpiRes, pg8::StaticOrder, true, true>(lds, g, S, E, wave_s); }
    SEAM(10);
#if REP_BAR
    _Pragma("unroll") for (int rb_ = 0; rb_ < 10; ++rb_) { TIDS(); XcdBarrier bar_; bar_.bar = (unsigned*)p.ws; bar_.x = xcc_s; bar_.st = (volatile LAS unsigned*)(lds + LDS_BYTES - 64); xcd_barrier(bar_, tid); }
#endif
    if (IN(11)) { TIDS(); final_norm_rows(p.out, NLAT, p.final_norm, lane, wave); }
#undef IN
#undef SEAM
}

#ifndef MK_SPLIT
#define MK_SPLIT 0
#endif
extern "C" void kernel_launch(void* const* d_in, const int* in_sizes, int n_in, void* d_out, int out_size, void* d_ws, size_t ws_size, hipStream_t stream) {
    static int grid = 0;
    if (grid == 0) {
        if (n_in != 19 || out_size != NLAT * DM || ws_size < WS_END) { fprintf(stderr, "kernel_launch: unexpected shapes (n_in %d, out %d, ws %zu)\n", n_in, out_size, ws_size); grid = -1; return; }
        int dev = 0, cus = 0, per_cu = 0;
        (void)hipGetDevice(&dev); (void)hipDeviceGetAttribute(&cus, hipDeviceAttributeMultiprocessorCount, dev);
        if (hipFuncSetAttribute((const void*)hymba_fwd, hipFuncAttributeMaxDynamicSharedMemorySize, LDS_BYTES) != hipSuccess) { fprintf(stderr, "kernel_launch: hipFuncSetAttribute failed\n"); grid = -1; return; }
        if (hipOccupancyMaxActiveBlocksPerMultiprocessor(&per_cu, (const void*)hymba_fwd, 512, LDS_BYTES) != hipSuccess || per_cu < 1) { fprintf(stderr, "kernel_launch: occupancy query says %d blocks per CU\n", per_cu); per_cu = 1; }
        (void)hipGetLastError();
        grid = cus > 0 ? cus : 256;
    }
    if (grid < 0) return;
    (void)hipMemsetAsync(d_ws, 0, 16384, stream);
    Params p{};
    p.x = (const float*)d_in[0]; p.c = (const float*)d_in[1]; p.ctx = (const float*)d_in[2]; p.c_ctx = (const float*)d_in[3]; p.w_ada = (const float*)d_in[4]; p.b_ada = (const float*)d_in[5];
    p.norm_mix = (const float*)d_in[6]; p.w_in = (const float*)d_in[7]; p.q_norm = (const float*)d_in[8]; p.w_uq = (const float*)d_in[9]; p.kv_norm = (const float*)d_in[10]; p.w_ukv = (const float*)d_in[11];
    p.hgrn_lb = (const float*)d_in[12]; p.hgrn_norm = (const float*)d_in[13]; p.w_out = (const float*)d_in[14]; p.norm_mlp = (const float*)d_in[15]; p.w_mlp_in = (const float*)d_in[16]; p.w_mlp_out = (const float*)d_in[17]; p.final_norm = (const float*)d_in[18];
    p.out = (float*)d_out; p.ws = (unsigned char*)d_ws;
#if MK_SPLIT
    p.coop = 0; for (int ph = 0; ph < 12; ++ph) { p.ph_lo = ph; p.ph_hi = ph + 1; hipLaunchKernelGGL(hymba_fwd, dim3(grid), dim3(512), LDS_BYTES, stream, p); }
#else
    p.ph_lo = 0; p.ph_hi = 12; p.coop = 1;
    void* args[] = {&p};
    hipError_t e = hipLaunchCooperativeKernel((const void*)hymba_fwd, dim3(grid), dim3(512), args, LDS_BYTES, stream);
    if (e != hipSuccess) fprintf(stderr, "kernel_launch: cooperative launch failed: %s (grid %d)\n", hipGetErrorString(e), grid);
#endif
}
```

```cpp
#include <hip/hip_runtime.h>
#include <hip/hip_cooperative_groups.h>
#include <cstdio>
#include <cstdint>
namespace cg = cooperative_groups;
#ifndef REP_HG
#define REP_HG 0
#endif
#ifndef REP_AT
#define REP_AT 0
#endif
#ifndef REP_MASK
#define REP_MASK 0
#endif
__device__ __forceinline__ int lane_id_opaque() { int l; asm volatile("v_mbcnt_lo_u32_b32 %0, -1, 0\n\tv_mbcnt_hi_u32_b32 %0, -1, %0" : "=v"(l)); return l; }
#ifndef REP_BAR
#define REP_BAR 0
#endif
namespace pg8 {
#define PG8_LAS __attribute__((address_space(3)))
typedef unsigned short bf16_t;
typedef short bf16x8 __attribute__((ext_vector_type(8)));
typedef float f32x4 __attribute__((ext_vector_type(4)));
typedef unsigned u32x4 __attribute__((ext_vector_type(4)));
constexpr int BM = 256, BK = 64, HALF = 128, HTB = HALF * BK * 2  , STAGE_BYTES = 8 * HTB, NXCD = 8, WGM = 8;

__host__ __device__ __forceinline__ int lds_byte(int r, int c) { const int st = (r >> 4) * 2 + (c >> 5), rr = r & 15, cc = c & 31, ob = rr * 64 + cc * 2; return st * 1024 + (ob ^ (((ob >> 9) & 1) << 5)); }
__host__ __device__ __forceinline__ void stage_rc(int b, int& R, int& C) { const int st = b / 1024, sb = b % 1024, swz = sb ^ (((sb >> 9) & 1) << 5); R = (st >> 1) * 16 + swz / 64; C = (st & 1) * 32 + (swz % 64) / 2; }
__host__ __device__ __forceinline__ int perm32(int rho) { const int n = rho >> 4, i = rho & 15; return 8 * (i >> 2) + 4 * n + (i & 3); }

struct Unit { int pm, pn; };
struct Gemm { const bf16_t* A; int lda; const bf16_t* Bt; int M, N, K; };

struct StaticOrder {
    int nM, nN, nwg, G, c;
    __host__ __device__ void init(int M, int N, int G_, int c_) { nM = M / BM; nN = N / BM; nwg = nM * nN; G = G_; c = c_; }
    __host__ __device__ bool next(int i, Unit& u) const {
        const long L = (long)i * G + c; if (L >= nwg) return false;
        int wgid = (int)L; { const int q = nwg / NXCD, r = nwg % NXCD, xcd = wgid % NXCD, off = wgid / NXCD; wgid = (xcd < r ? xcd * (q + 1) : r * (q + 1) + (xcd - r) * q) + off; }
        const int nig = WGM * nN, gid = wgid / nig, fm = gid * WGM, gsz = (nM - fm) < WGM ? (nM - fm) : WGM;
        u.pm = fm + ((wgid % nig) % gsz); u.pn = (wgid % nig) / gsz; return true;
    }
    __device__ __forceinline__ void a_ready(const Unit&) const {}
    __device__ __forceinline__ void done(const Unit&) const {}
};

__device__ __forceinline__ unsigned cvt_pk_bf16(float lo, float hi) { unsigned r; asm volatile("v_cvt_pk_bf16_f32 %0, %1, %2" : "=v"(r) : "v"(lo), "v"(hi)); return r; }
typedef float f32x2 __attribute__((ext_vector_type(2)));
__device__ __forceinline__ f32x2 gelu_pk(f32x2 v) {
    const f32x2 av = __builtin_elementwise_abs(v), d = av * 0.2316418882f + 1.0f;
    f32x2 t; t.x = __builtin_amdgcn_rcpf(d.x); t.y = __builtin_amdgcn_rcpf(d.y);
    f32x2 q = t * 0.5307027145f + (-0.7265760135f); q = q * t + 0.7107068705f; q = q * t + (-0.142248368f); q = q * t + 0.127414796f; q = q * t;
    const f32x2 s = (v * v) * (-0.72134752044f);
    f32x2 e; e.x = __builtin_amdgcn_exp2f(s.x); e.y = __builtin_amdgcn_exp2f(s.y);
    const f32x2 m = v * (q * e), r = v - m;
    f32x2 o; o.x = v.x < 0.f ? m.x : r.x; o.y = v.y < 0.f ? m.y : r.y; return o;
}

template <int ACT  > struct EpiBf16 {
    static constexpr bool PERM = true, AFTER_DRAIN = false; static_assert(ACT == 0 || ACT == 1, "EpiBf16: ACT is 0 (none) or 1 (gelu_pk)");
    bf16_t* O; int ldc; const float* bias; int split_cols; size_t split_stride; float scale0;
    __device__ __forceinline__ void operator()(const f32x4 (&acc)[2][2][4][2], const Unit& u, int wr, int wc, int fr, int fq) const {
        const int row0 = u.pm * BM + wr * 64 + fr; int colt = u.pn * BM; bf16_t* base = O;
        float sc = 1.f; if (split_cols) { const int t = colt / split_cols; base += (size_t)t * split_stride; colt -= t * split_cols; if (t == 0) sc = scale0; }
        const int col0 = colt + wc * 32 + 8 * fq, bcol0 = u.pn * BM + wc * 32 + 8 * fq;
        f32x4 bv[2][2];
#pragma unroll
        for (int bj = 0; bj < 2; ++bj)
#pragma unroll
            for (int n = 0; n < 2; ++n) bv[bj][n] = bias ? *(const f32x4*)(bias + bcol0 + bj * HALF + 4 * n) : (f32x4){0.f, 0.f, 0.f, 0.f};
#pragma unroll
        for (int ai = 0; ai < 2; ++ai)
#pragma unroll
            for (int m = 0; m < 4; ++m) { bf16_t* rowp = base + (size_t)(row0 + ai * HALF + m * 16) * ldc + col0;
#pragma unroll
                for (int bj = 0; bj < 2; ++bj) { f32x4 v0 = acc[ai][bj][m][0] + bv[bj][0], v1 = acc[ai][bj][m][1] + bv[bj][1];
                    if (ACT == 1) { f32x2 a = gelu_pk((f32x2){v0[0], v0[1]}), b = gelu_pk((f32x2){v0[2], v0[3]}), c = gelu_pk((f32x2){v1[0], v1[1]}), d = gelu_pk((f32x2){v1[2], v1[3]});
                        v0 = (f32x4){a.x, a.y, b.x, b.y}; v1 = (f32x4){c.x, c.y, d.x, d.y}; }
                    v0 = v0 * sc; v1 = v1 * sc; u32x4 w; w.x = cvt_pk_bf16(v0[0], v0[1]); w.y = cvt_pk_bf16(v0[2], v0[3]); w.z = cvt_pk_bf16(v1[0], v1[1]); w.w = cvt_pk_bf16(v1[2], v1[3]);
                    *(u32x4*)(rowp + bj * HALF) = w; } }
    }
};
constexpr int NLAT_ROWS = 32768;
struct EpiKV {
    static constexpr bool PERM = true, AFTER_DRAIN = false;
    bf16_t* Kb; bf16_t* Vt;
    __device__ __forceinline__ void operator()(const f32x4 (&acc)[2][2][4][2], const Unit& u, int wr, int wc, int fr_in, int fq_in) const {
        int fr = fr_in, fq = fq_in; asm volatile("" : "+v"(fr), "+v"(fq));
        const int rbase = u.pm * BM; int b, keybase;
        if (rbase < NLAT_ROWS) { b = rbase >> 11; keybase = rbase & 2047; } else { b = (rbase - NLAT_ROWS) >> 8; keybase = 2048 + ((rbase - NLAT_ROWS) & 255); }
        const int rl0 = wr * 64 + fr; const int colt = u.pn * BM + wc * 32 + 8 * fq;
#pragma unroll
        for (int ai = 0; ai < 2; ++ai)
#pragma unroll
            for (int m = 0; m < 4; ++m) { const int rl = rl0 + ai * HALF + m * 16; const size_t row = (size_t)(rbase + rl);
#pragma unroll
                for (int bj = 0; bj < 2; ++bj) { const f32x4 v0 = acc[ai][bj][m][0], v1 = acc[ai][bj][m][1]; const int c = colt + bj * HALF;
                    u32x4 w; w.x = cvt_pk_bf16(v0[0], v0[1]); w.y = cvt_pk_bf16(v0[2], v0[3]); w.z = cvt_pk_bf16(v1[0], v1[1]); w.w = cvt_pk_bf16(v1[2], v1[3]);
                    if (u.pn < 2) { const int h = c >> 6, d = c & 63; *(u32x4*)(Kb + row * 768 + h * 96 + d) = w; }
                    else { const int cv = c - 512, h = cv >> 6, d = cv & 63; const int kk_ = keybase + rl, kp_ = (kk_ & ~12) | ((kk_ & 4) << 1) | ((kk_ & 8) >> 1); bf16_t* p = Vt + ((size_t)((b * 8 + h) * 64 + d)) * 2304 + kp_;
                        p[0] = (bf16_t)(w.x & 0xffffu); p[2304] = (bf16_t)(w.x >> 16); p[2 * 2304] = (bf16_t)(w.y & 0xffffu); p[3 * 2304] = (bf16_t)(w.y >> 16);
                        p[4 * 2304] = (bf16_t)(w.z & 0xffffu); p[5 * 2304] = (bf16_t)(w.z >> 16); p[6 * 2304] = (bf16_t)(w.w & 0xffffu); p[7 * 2304] = (bf16_t)(w.w >> 16); } } }
    }
};
struct EpiRes {
    static constexpr bool PERM = false, AFTER_DRAIN = false;
    const float* base; float* out; const float* gate;
    __device__ __forceinline__ void operator()(const f32x4 (&acc)[2][2][4][2], const Unit& u, int wr, int wc, int fr_in, int fq_in) const {
        int fr = fr_in, fq = fq_in; asm volatile("" : "+v"(fr), "+v"(fq));
        const int row0 = u.pm * BM + wr * 64 + fr, col0 = u.pn * BM + wc * 32 + 4 * fq;
        const float* gp = gate + (size_t)((u.pm * BM) >> 11) * 6144 + col0;
        f32x4 gv[2][2];
#pragma unroll
        for (int bj = 0; bj < 2; ++bj)
#pragma unroll
            for (int n = 0; n < 2; ++n) gv[bj][n] = *(const f32x4*)(gp + bj * HALF + n * 16);
        f32x4 cur[2][2], nxt[2][2];
#pragma unroll
        for (int bj = 0; bj < 2; ++bj)
#pragma unroll
            for (int n = 0; n < 2; ++n) { cur[bj][n] = *(const f32x4*)(base + (size_t)row0 * 1024 + col0 + bj * HALF + n * 16); nxt[bj][n] = cur[bj][n]; }
#pragma unroll
        for (int i = 0; i < 8; ++i) { const int ai = i >> 2, m = i & 3; const size_t off = (size_t)(row0 + ai * HALF + m * 16) * 1024 + col0;
            if (i + 1 < 8) { const size_t offn = (size_t)(row0 + ((i + 1) >> 2) * HALF + ((i + 1) & 3) * 16) * 1024 + col0;
#pragma unroll
                for (int bj = 0; bj < 2; ++bj)
#pragma unroll
                    for (int n = 0; n < 2; ++n) nxt[bj][n] = *(const f32x4*)(base + offn + bj * HALF + n * 16);
                asm volatile("" ::: "memory"); }
#pragma unroll
            for (int bj = 0; bj < 2; ++bj)
#pragma unroll
                for (int n = 0; n < 2; ++n) { *(f32x4*)(out + off + bj * HALF + n * 16) = cur[bj][n] + gv[bj][n] * acc[ai][bj][m][n]; cur[bj][n] = nxt[bj][n]; }
            asm volatile("" ::: "memory"); }
    }
};
struct EpiRelu2 {
    static constexpr bool PERM = true, AFTER_DRAIN = false;
    bf16_t* O; int ldc;
    __device__ __forceinline__ void operator()(const f32x4 (&acc)[2][2][4][2], const Unit& u, int wr, int wc, int fr_in, int fq_in) const {
        int fr = fr_in, fq = fq_in; asm volatile("" : "+v"(fr), "+v"(fq));
        const int row0 = u.pm * BM + wr * 64 + fr, col0 = u.pn * BM + wc * 32 + 8 * fq;
#pragma unroll
        for (int ai = 0; ai < 2; ++ai)
#pragma unroll
            for (int m = 0; m < 4; ++m) { bf16_t* rowp = O + (size_t)(row0 + ai * HALF + m * 16) * ldc + col0;
#pragma unroll
                for (int bj = 0; bj < 2; ++bj) { f32x4 v0 = acc[ai][bj][m][0], v1 = acc[ai][bj][m][1];
#pragma unroll
                    for (int e = 0; e < 4; ++e) { const float a = fmaxf(v0[e], 0.f), b2 = fmaxf(v1[e], 0.f); v0[e] = a * a; v1[e] = b2 * b2; }
                    u32x4 w; w.x = cvt_pk_bf16(v0[0], v0[1]); w.y = cvt_pk_bf16(v0[2], v0[3]); w.z = cvt_pk_bf16(v1[0], v1[1]); w.w = cvt_pk_bf16(v1[2], v1[3]);
                    *(u32x4*)(rowp + bj * HALF) = w; } }
    }
};
struct EpiIn {
    static constexpr bool PERM = true, AFTER_DRAIN = false;
    bf16_t* O; const float* lbraw;
    __device__ __forceinline__ void operator()(const f32x4 (&acc)[2][2][4][2], const Unit& u, int wr, int wc, int fr_in, int fq_in) const {
        int fr = fr_in, fq = fq_in; asm volatile("" : "+v"(fr), "+v"(fq));
        const int row0 = u.pm * BM + wr * 64 + fr, col0 = u.pn * BM + wc * 32 + 8 * fq; const int mode = (u.pn >= 4 && u.pn < 8) ? 2 : ((u.pn == 2 || u.pn == 3) ? 1 : 0);
        float lb[2][8];
#pragma unroll
        for (int bj = 0; bj < 2; ++bj)
#pragma unroll
            for (int e8 = 0; e8 < 8; ++e8) lb[bj][e8] = 0.5f;
        if (mode == 2) { const int dir = u.pn >= 6, cb = (u.pn - (dir ? 6 : 4)) * BM + wc * 32 + 8 * fq;
#pragma unroll
            for (int bj = 0; bj < 2; ++bj)
#pragma unroll
                for (int e8 = 0; e8 < 8; ++e8) { const float a0 = lbraw[dir * 512 + cb + bj * HALF + e8], a1 = lbraw[1024 + dir * 512 + cb + bj * HALF + e8]; const float e0 = __expf(a0), e1 = __expf(a1); lb[bj][e8] = e0 / (e0 + e1); } }
#pragma unroll
        for (int ai = 0; ai < 2; ++ai)
#pragma unroll
            for (int m = 0; m < 4; ++m) { bf16_t* rowp = O + (size_t)(row0 + ai * HALF + m * 16) * 3072 + col0;
#pragma unroll
                for (int bj = 0; bj < 2; ++bj) { float v[8];
#pragma unroll
                    for (int e8 = 0; e8 < 8; ++e8) v[e8] = acc[ai][bj][m][e8 >> 2][e8 & 3];
                    if (mode == 1) {
#pragma unroll
                        for (int e8 = 0; e8 < 8; ++e8) v[e8] = v[e8] * __builtin_amdgcn_rcpf(1.f + __expf(-v[e8]));
                    } else if (mode == 2) {
#pragma unroll
                        for (int e8 = 0; e8 < 8; ++e8) { const float sg = __builtin_amdgcn_rcpf(1.f + __expf(-v[e8])); v[e8] = __logf(lb[bj][e8] + (1.f - lb[bj][e8]) * sg); }
                    }
                    u32x4 w; w.x = cvt_pk_bf16(v[0], v[1]); w.y = cvt_pk_bf16(v[2], v[3]); w.z = cvt_pk_bf16(v[4], v[5]); w.w = cvt_pk_bf16(v[6], v[7]);
                    *(u32x4*)(rowp + bj * HALF) = w; } }
    }
};
template <class Epi, class Sched, bool ALIGN_EPI = false, bool SP2 = false>
__device__ __forceinline__ void gemm_phase(PG8_LAS unsigned char* lds, const Gemm g, const Sched& S, const Epi& E, const int wave_s) {
    const int wid = wave_s, lane = lane_id_opaque(), tid = wid * 64 + lane, wr = wid >> 2, wc = wid & 3, fr = lane & 15, fq = lane >> 4;
    const int K = g.K, nt = K / BK;
    unsigned voffA[2], voffB[2];
#pragma unroll
    for (int i = 0; i < 2; ++i) { int R, C; stage_rc(tid * 16 + i * 8192, R, C); const int Rb = Epi::PERM ? ((R & ~31) + perm32(R & 31)) : R;
        voffA[i] = (unsigned)(R * g.lda + C) * 2u; voffB[i] = (unsigned)(Rb * K + C) * 2u; }
    const size_t kstep = (size_t)(BK * 2);
    const size_t hstepA = (size_t)HALF * g.lda * 2, hstepB = (size_t)HALF * K * 2;
    const size_t tstepA = 2 * hstepA, tstepB = 2 * hstepB;
    const unsigned ldsw = (unsigned)wid * 1024u;
    const int aoff = lds_byte(wr * 64 + fr, fq * 8), boff = lds_byte(wc * 32 + fr, fq * 8);
#define PG8_SA(b, h) (((b) * 2 + (h)) * HTB)
#define PG8_SB(b, h) ((4 + (b) * 2 + (h)) * HTB)
#define PG8_STAGE(bufoff, gbase, voff) do { _Pragma("unroll") for (int _i = 0; _i < 2; ++_i) \
        __builtin_amdgcn_global_load_lds((const unsigned*)((const char*)(gbase) + (voff)[_i]), (PG8_LAS unsigned*)(lds + (bufoff) + ldsw + _i * 8192), 16, 0, 0); } while (0)
#define PG8_LDA(dst, b, h) do { _Pragma("unroll") for (int m = 0; m < 4; ++m) _Pragma("unroll") for (int k = 0; k < 2; ++k) dst[m][k] = *(const PG8_LAS bf16x8*)(lds + PG8_SA(b, h) + aoff + m * 2048 + k * 1024); } while (0)
#define PG8_LDB(dst, b, h) do { _Pragma("unroll") for (int n = 0; n < 2; ++n) _Pragma("unroll") for (int k = 0; k < 2; ++k) dst[n][k] = *(const PG8_LAS bf16x8*)(lds + PG8_SB(b, h) + boff + n * 2048 + k * 1024); } while (0)
#define PG8_MMA(ai, bj, At, Bt) do { __builtin_amdgcn_s_setprio(1); _Pragma("unroll") for (int m = 0; m < 4; ++m) _Pragma("unroll") for (int n = 0; n < 2; ++n) _Pragma("unroll") for (int k = 0; k < 2; ++k) \
        acc[ai][bj][m][n] = __builtin_amdgcn_mfma_f32_16x16x32_bf16(Bt[n][k], At[m][k], acc[ai][bj][m][n], 0, 0, 0); __builtin_amdgcn_s_setprio(0); } while (0)
#define PG8_WAIT_V(n) asm volatile("s_waitcnt vmcnt(" #n ")" ::: "memory")
#define PG8_WAIT_L(n) asm volatile("s_waitcnt lgkmcnt(" #n ")" ::: "memory")
#define PG8_BAR __builtin_amdgcn_s_barrier()
#define PG8_SCHED __builtin_amdgcn_sched_barrier(0)
    Unit cur, nxt; int ui = 0;
    if (!S.next(0, cur)) return;
    f32x4 acc[2][2][4][2];
#pragma unroll
    for (int a = 0; a < 2; ++a)
#pragma unroll
        for (int b = 0; b < 2; ++b)
#pragma unroll
            for (int m = 0; m < 4; ++m)
#pragma unroll
                for (int n = 0; n < 2; ++n) acc[a][b][m][n] = (f32x4){0.f, 0.f, 0.f, 0.f};
    bf16x8 At[4][2], B0[2][2], B1[2][2];
    const char* cA = (const char*)g.A + (size_t)cur.pm * tstepA; const char* cB = (const char*)g.Bt + (size_t)cur.pn * tstepB;
    S.a_ready(cur);
    if constexpr (SP2) {
        PG8_STAGE(PG8_SB(0, 0), cB, voffB); PG8_STAGE(PG8_SB(0, 1), cB + hstepB, voffB); PG8_STAGE(PG8_SA(0, 0), cA, voffA); PG8_STAGE(PG8_SA(0, 1), cA + hstepA, voffA);
        if (wr == 1) PG8_BAR;
        PG8_WAIT_V(2); PG8_BAR;
        PG8_STAGE(PG8_SB(1, 0), cB + kstep, voffB); PG8_STAGE(PG8_SA(1, 0), cA + kstep, voffA); PG8_STAGE(PG8_SB(1, 1), cB + hstepB + kstep, voffB);
        PG8_WAIT_V(6); PG8_BAR;
    } else {
        PG8_STAGE(PG8_SB(0, 0), cB, voffB); PG8_STAGE(PG8_SA(0, 0), cA, voffA); PG8_STAGE(PG8_SB(0, 1), cB + hstepB, voffB); PG8_STAGE(PG8_SA(0, 1), cA + hstepA, voffA);
        if (wr == 1) PG8_BAR;
        PG8_WAIT_V(4); PG8_BAR;
        PG8_STAGE(PG8_SB(1, 0), cB + kstep, voffB); PG8_STAGE(PG8_SA(1, 0), cA + kstep, voffA); PG8_STAGE(PG8_SB(1, 1), cB + hstepB + kstep, voffB);
        PG8_WAIT_V(6); PG8_BAR;
    }
    for (;;) {
        const bool has_next = S.next(ui + 1, nxt);
        const char* nA = has_next ? (const char*)g.A + (size_t)nxt.pm * tstepA : cA; const char* nB = has_next ? (const char*)g.Bt + (size_t)nxt.pn * tstepB : cB;
        for (int t = 0; t < nt; t += 2) {
            const bool last = (t == nt - 2);
            const char* a1 = cA + (size_t)(t + 1) * kstep;
            const char* a2 = last ? nA : cA + (size_t)(t + 2) * kstep; const char* b2 = last ? nB : cB + (size_t)(t + 2) * kstep;
            const char* a3 = a2 + kstep; const char* b3 = b2 + kstep;
            if (last && has_next) S.a_ready(nxt);
            if constexpr (SP2) {
            PG8_LDB(B0, 0, 0); PG8_LDB(B1, 0, 1); PG8_SCHED; PG8_LDA(At, 0, 0); PG8_STAGE(PG8_SA(1, 1), a1 + hstepA, voffA);
            PG8_WAIT_V(8); PG8_WAIT_L(0); PG8_BAR; PG8_MMA(0, 0, At, B0); PG8_MMA(0, 1, At, B1); PG8_BAR; PG8_SCHED;
            PG8_LDA(At, 0, 1); PG8_STAGE(PG8_SB(0, 0), b2, voffB); PG8_STAGE(PG8_SB(0, 1), b2 + hstepB, voffB); PG8_STAGE(PG8_SA(0, 0), a2, voffA);
            PG8_WAIT_V(8); PG8_WAIT_L(0); PG8_BAR; PG8_MMA(1, 0, At, B0); PG8_MMA(1, 1, At, B1); PG8_BAR; PG8_SCHED;
            PG8_LDB(B0, 1, 0); PG8_LDB(B1, 1, 1); PG8_SCHED; PG8_LDA(At, 1, 0); PG8_STAGE(PG8_SA(0, 1), a2 + hstepA, voffA);
            PG8_WAIT_V(8); PG8_WAIT_L(0); PG8_BAR; PG8_MMA(0, 0, At, B0); PG8_MMA(0, 1, At, B1); PG8_BAR; PG8_SCHED;
            PG8_LDA(At, 1, 1); PG8_STAGE(PG8_SB(1, 0), b3, voffB); PG8_STAGE(PG8_SB(1, 1), b3 + hstepB, voffB); PG8_STAGE(PG8_SA(1, 0), a3, voffA);
            PG8_WAIT_V(8); PG8_WAIT_L(0); PG8_BAR; PG8_MMA(1, 0, At, B0); PG8_MMA(1, 1, At, B1); PG8_BAR; PG8_SCHED;
            } else {
            PG8_LDB(B0, 0, 0); PG8_SCHED; PG8_LDA(At, 0, 0); PG8_STAGE(PG8_SA(1, 1), a1 + hstepA, voffA);
            PG8_WAIT_L(8); PG8_BAR; PG8_WAIT_L(0); PG8_MMA(0, 0, At, B0); PG8_BAR; PG8_SCHED;
            PG8_LDB(B1, 0, 1); PG8_STAGE(PG8_SB(0, 0), b2, voffB);
            PG8_BAR; PG8_WAIT_L(0); PG8_MMA(0, 1, At, B1); PG8_BAR;
            PG8_LDA(At, 0, 1); PG8_STAGE(PG8_SA(0, 0), a2, voffA);
            PG8_BAR; PG8_WAIT_L(0); PG8_MMA(1, 0, At, B0); PG8_BAR; PG8_SCHED;
            PG8_STAGE(PG8_SB(0, 1), b2 + hstepB, voffB);
            PG8_WAIT_V(6); PG8_BAR; PG8_MMA(1, 1, At, B1); PG8_BAR;
            PG8_LDB(B0, 1, 0); PG8_SCHED; PG8_LDA(At, 1, 0); PG8_STAGE(PG8_SA(0, 1), a2 + hstepA, voffA);
            PG8_WAIT_L(8); PG8_BAR; PG8_WAIT_L(0); PG8_MMA(0, 0, At, B0); PG8_BAR; PG8_SCHED;
            PG8_LDB(B1, 1, 1); PG8_STAGE(PG8_SB(1, 0), b3, voffB);
            PG8_BAR; PG8_WAIT_L(0); PG8_MMA(0, 1, At, B1); PG8_BAR;
            PG8_LDA(At, 1, 1); PG8_STAGE(PG8_SA(1, 0), a3, voffA);
            PG8_BAR; PG8_WAIT_L(0); PG8_MMA(1, 0, At, B0); PG8_BAR; PG8_SCHED;
            PG8_STAGE(PG8_SB(1, 1), b3 + hstepB, voffB);
            PG8_WAIT_V(6); PG8_BAR; PG8_MMA(1, 1, At, B1); PG8_BAR;
            }
        }
        if constexpr (ALIGN_EPI) { if (wr == 0) PG8_BAR; }
        if constexpr (!Epi::AFTER_DRAIN) { E(acc, cur, wr, wc, fr, fq); S.done(cur); }
        if (!has_next) break;
#pragma unroll
        for (int a = 0; a < 2; ++a)
#pragma unroll
            for (int b = 0; b < 2; ++b)
#pragma unroll
                for (int m = 0; m < 4; ++m)
#pragma unroll
                    for (int n = 0; n < 2; ++n) acc[a][b][m][n] = (f32x4){0.f, 0.f, 0.f, 0.f};
        cur = nxt; cA = nA; cB = nB; ++ui;
        if constexpr (ALIGN_EPI) { if (wr == 1) PG8_BAR; }
    }
    PG8_WAIT_V(0);
    if constexpr (!ALIGN_EPI) { if (wr == 0) PG8_BAR; }
    PG8_BAR;
    if constexpr (Epi::AFTER_DRAIN) { E.fused(acc, cur, wr, wc, fr, fq, lds, wid, lane); S.done(cur); }
#undef PG8_SA
#undef PG8_SB
#undef PG8_STAGE
#undef PG8_LDA
#undef PG8_LDB
#undef PG8_MMA
#undef PG8_WAIT_V
#undef PG8_WAIT_L
#undef PG8_BAR
#undef PG8_SCHED
}
}
#define LAS __attribute__((address_space(3)))
typedef unsigned short bf16;
typedef unsigned u32x4 __attribute__((ext_vector_type(4)));
typedef unsigned u32x2 __attribute__((ext_vector_type(2)));
typedef float f32x4 __attribute__((ext_vector_type(4)));
typedef float f32x16 __attribute__((ext_vector_type(16)));
typedef short bf16x8 __attribute__((ext_vector_type(8)));
typedef short s16x4 __attribute__((ext_vector_type(4)));
typedef float f32x2_t __attribute__((ext_vector_type(2)));
typedef __bf16 bf16x2_t __attribute__((ext_vector_type(2)));

constexpr int NB = 16, TSEQ = 2048, LCTX = 256, DM = 1024, NLAT = NB * TSEQ, NCTXR = NB * LCTX, MALL = NLAT + NCTXR, DFF = 4096;
constexpr int NP = 3072;
constexpr int PC_CQ = 0, PC_CKV = 256, PC_KR = 384, PC_HQ = 512, PC_HF = 1024, PC_HB = 1536, PC_HI = 2048, PC_HG = 2560;
constexpr int NKEY = TSEQ + LCTX;
constexpr float EPS = 1e-6f;
constexpr float QSCALE = 0.10206207261596575f * 1.4426950408889634f;
constexpr size_t MiB = 1u << 20;
constexpr size_t WS_WIN = 1 * MiB, WS_WUQ = 7 * MiB, WS_WUKV = 7 * MiB + 512 * 1024, WS_WOUT = 8 * MiB, WS_W1 = 10 * MiB, WS_W2 = 18 * MiB, WS_MOD = 26 * MiB;
constexpr size_t WS_XN = 32 * MiB, WS_P = 104 * MiB, WS_Q = 320 * MiB, WS_K = 368 * MiB, WS_VT = 422 * MiB, WS_END = 458 * MiB, WS_HID = 104 * MiB;
constexpr int LDS_BYTES = 139264;

__device__ __forceinline__ unsigned cvtpk(float lo, float hi) { f32x2_t v = {lo, hi}; bf16x2_t b = __builtin_convertvector(v, bf16x2_t); return __builtin_bit_cast(unsigned, b); }
__device__ __forceinline__ bf16 f2b(float x) { return (bf16)(cvtpk(x, 0.f) & 0xffffu); }
__device__ __forceinline__ float b2f(unsigned short v) { return __builtin_bit_cast(float, (unsigned)v << 16); }
__device__ __forceinline__ float blo(unsigned w) { return __builtin_bit_cast(float, w << 16); }
__device__ __forceinline__ float bhi(unsigned w) { return __builtin_bit_cast(float, w & 0xffff0000u); }
__device__ __forceinline__ float wave_sum(float v) {
#pragma unroll
    for (int o = 1; o < 64; o <<= 1) v += __shfl_xor(v, o);
    return v;
}
__device__ __forceinline__ float sigmoidf_(float x) { return __builtin_amdgcn_rcpf(1.f + __expf(-x)); }
#define LDS_BARRIER() asm volatile("s_waitcnt lgkmcnt(0)\n\ts_barrier" ::: "memory")

struct Params {
    const float *x, *c, *ctx, *c_ctx, *w_ada, *b_ada, *norm_mix, *w_in, *q_norm, *w_uq, *kv_norm, *w_ukv, *hgrn_lb, *hgrn_norm, *w_out, *norm_mlp, *w_mlp_in, *w_mlp_out, *final_norm;
    float* out; unsigned char* ws; int ph_lo, ph_hi, coop, pad;
};

__device__ __forceinline__ void tr_item(const float* __restrict__ W, int K, int N, bf16* WT, int dst_row0, int k0, int n0, const float* gain, LAS float* scr, int lane) {
#pragma unroll 8
    for (int i = 0; i < 32; ++i) { const int kk = 2 * i + (lane >> 5); float v = W[(size_t)(k0 + kk) * N + n0 + (lane & 31)]; if (gain) v *= gain[k0 + kk]; scr[kk * 33 + (lane & 31)] = v; }
    asm volatile("s_waitcnt lgkmcnt(0)" ::: "memory");
    const int c = lane & 7;
#pragma unroll
    for (int j = 0; j < 4; ++j) { const int n = (lane >> 3) + 8 * j; const LAS float* s = scr + (8 * c) * 33 + n;
        u32x4 o; o.x = cvtpk(s[0 * 33], s[1 * 33]); o.y = cvtpk(s[2 * 33], s[3 * 33]); o.z = cvtpk(s[4 * 33], s[5 * 33]); o.w = cvtpk(s[6 * 33], s[7 * 33]);
        *(u32x4*)(WT + (size_t)(dst_row0 + n) * K + k0 + 8 * c) = o; }
    asm volatile("s_waitcnt lgkmcnt(0)" ::: "memory");
}

__device__ __forceinline__ void p0_prologue(const Params& p, LAS unsigned char* lds, int tid, int lane, int wave) {
    unsigned char* ws = p.ws;
    float* mod = (float*)(ws + WS_MOD);
    {
        LAS float* s_lds = (LAS float*)lds; LAS float* red = s_lds + 17 * 1024;
        bool have = false;
        for (int it = blockIdx.x; it < 192; it += gridDim.x) {
            if (!have) {
                for (int i = tid; i < 17 * 1024; i += 512) { const int r = i >> 10, k = i & 1023; const float v = (r < 16) ? p.c[r * 1024 + k] : p.c_ctx[k]; s_lds[i] = v * sigmoidf_(v); }
                have = true;
            }
            __syncthreads();
            const int cl = lane & 31, col = it * 32 + cl, slice = wave * 2 + (lane >> 5);
            float acc[17];
#pragma unroll
            for (int r = 0; r < 17; ++r) acc[r] = 0.f;
#pragma unroll 8
            for (int kk = 0; kk < 64; ++kk) { const int k = slice * 64 + kk; const float wv = p.w_ada[(size_t)k * 6144 + col];
#pragma unroll
                for (int r = 0; r < 17; ++r) acc[r] += s_lds[r * 1024 + k] * wv; }
#pragma unroll
            for (int r = 0; r < 17; ++r) red[(slice * 17 + r) * 32 + cl] = acc[r];
            __syncthreads();
            for (int o = tid; o < 17 * 32; o += 512) { const int r = o >> 5, cc = o & 31; float s = p.b_ada[it * 32 + cc];
#pragma unroll
                for (int sl = 0; sl < 16; ++sl) s += red[(sl * 17 + r) * 32 + cc];
                mod[r * 6144 + it * 32 + cc] = s; }
        }
        __syncthreads();
    }
    bf16* win_t = (bf16*)(ws + WS_WIN); bf16* wuq_t = (bf16*)(ws + WS_WUQ); bf16* wukv_t = (bf16*)(ws + WS_WUKV); bf16* wout_t = (bf16*)(ws + WS_WOUT); bf16* w1_t = (bf16*)(ws + WS_W1); bf16* w2_t = (bf16*)(ws + WS_W2);
    LAS float* scr = (LAS float*)(lds + wave * 8704);
    const int gw = blockIdx.x * 8 + wave, NGW = gridDim.x * 8;
    constexpr int I_IN = 16 * 93, I_UQ = 4 * 24, I_UKV = 2 * 32, I_OUT = 16 * 32, I_1 = 16 * 128, I_2 = 64 * 32, I_ALL = I_IN + I_UQ + I_UKV + I_OUT + I_1 + I_2;
    for (int it = gw; it < I_ALL; it += NGW) {
        int r = it;
        if (r < I_1) { const int kb = r / 128, nb = r % 128; tr_item(p.w_mlp_in, 1024, 4096, w1_t, nb * 32, kb * 64, nb * 32, nullptr, scr, lane); continue; } r -= I_1;
        if (r < I_2) { const int kb = r / 32, nb = r % 32; tr_item(p.w_mlp_out, 4096, 1024, w2_t, nb * 32, kb * 64, nb * 32, nullptr, scr, lane); continue; } r -= I_2;
        if (r < I_IN) { const int kb = r / 93, nb = r % 93, n0 = nb * 32; tr_item(p.w_in, 1024, 2976, win_t, n0 < 416 ? n0 : n0 + 96, kb * 64, n0, nullptr, scr, lane); continue; } r -= I_IN;
        if (r < I_OUT) { const int kb = r / 32, nb = r % 32; tr_item(p.w_out, 1024, 1024, wout_t, nb * 32, kb * 64, nb * 32, nullptr, scr, lane); continue; } r -= I_OUT;
        if (r < I_UQ) { const int kb = r / 24, nb = r % 24; tr_item(p.w_uq, 256, 768, wuq_t, nb * 32, kb * 64, nb * 32, p.q_norm, scr, lane); continue; } r -= I_UQ;
        { const int kb = r / 32, nb = r % 32, hh = nb >> 2, jb = nb & 3; const int dst = (jb < 2) ? hh * 64 + jb * 32 : 512 + hh * 64 + (jb - 2) * 32;
          tr_item(p.w_ukv, 128, 1024, wukv_t, dst, kb * 64, nb * 32, p.kv_norm, scr, lane); }
    }
    { u32x4* z = (u32x4*)(win_t + (size_t)416 * 1024); const int n16 = 96 * 1024 * 2 / 16; for (int i = blockIdx.x * 512 + tid; i < n16; i += gridDim.x * 512) z[i] = (u32x4){0u, 0u, 0u, 0u}; }
}

__device__ __forceinline__ void norm_mod_rows(const float* srcA, int nA, const float* srcB, int nB, const float* __restrict__ gain, const float* __restrict__ mod, int sh_off, int sc_off, bf16* dst, int lane, int wave) {
    const int gw = blockIdx.x * 8 + wave, NGW = gridDim.x * 8;
    for (int row = gw; row < nA + nB; row += NGW) {
        const float* src = (row < nA) ? srcA + (size_t)row * 1024 : srcB + (size_t)(row - nA) * 1024; const int bi = (row < nA) ? (row >> 11) : 16;
        const f32x4* xr = (const f32x4*)src + lane; f32x4 v[4]; float s = 0.f;
#pragma unroll
        for (int j = 0; j < 4; ++j) { v[j] = xr[64 * j]; s += (v[j].x * v[j].x + v[j].y * v[j].y) + (v[j].z * v[j].z + v[j].w * v[j].w); }
        const float rs = __builtin_amdgcn_rsqf(wave_sum(s) * (1.f / 1024.f) + EPS);
        const f32x4* gp = (const f32x4*)gain + lane; const f32x4* shp = (const f32x4*)(mod + bi * 6144 + sh_off) + lane; const f32x4* scp = (const f32x4*)(mod + bi * 6144 + sc_off) + lane;
        u32x2* o8 = (u32x2*)(dst + (size_t)row * 1024) + lane;
#pragma unroll
        for (int j = 0; j < 4; ++j) { const f32x4 g = gp[64 * j], sh = shp[64 * j], sc = scp[64 * j]; const f32x4 h = (v[j] * rs) * g * (sc + 1.f) + sh;
            u32x2 w; w.x = cvtpk(h.x, h.y); w.y = cvtpk(h.z, h.w); o8[64 * j] = w; }
    }
}
__device__ __forceinline__ void final_norm_rows(float* buf, int n, const float* __restrict__ gain, int lane, int wave) {
    const int gw = blockIdx.x * 8 + wave, NGW = gridDim.x * 8;
    for (int row = gw; row < n; row += NGW) {
        f32x4* xr = (f32x4*)(buf + (size_t)row * 1024) + lane; f32x4 v[4]; float s = 0.f;
#pragma unroll
        for (int j = 0; j < 4; ++j) { v[j] = xr[64 * j]; s += (v[j].x * v[j].x + v[j].y * v[j].y) + (v[j].z * v[j].z + v[j].w * v[j].w); }
        const float rs = __builtin_amdgcn_rsqf(wave_sum(s) * (1.f / 1024.f) + EPS);
        const f32x4* gp = (const f32x4*)gain + lane;
#pragma unroll
        for (int j = 0; j < 4; ++j) xr[64 * j] = (v[j] * rs) * gp[64 * j];
    }
}
__device__ __forceinline__ float rope_inv(int j) { return j == 0 ? 1.f : j == 1 ? 0.316227766016838f : j == 2 ? 0.1f : j == 3 ? 0.0316227766016838f : j == 4 ? 0.01f : j == 5 ? 0.00316227766016838f : j == 6 ? 0.001f : 0.000316227766016838f; }
__device__ __forceinline__ void mla_prep_rows(bf16* P, bf16* Kb, int lane, int wave) {
    const int gw = blockIdx.x * 8 + wave, NGW = gridDim.x * 8;
    for (int row = gw; row < MALL; row += NGW) {
        bf16* pr = P + (size_t)row * NP;
        u32x2 q4 = *((u32x2*)(pr + PC_CQ) + lane); unsigned k2 = *((unsigned*)(pr + PC_CKV) + lane);
        unsigned short krv = (lane < 32) ? pr[PC_KR + lane] : (unsigned short)0;
        float a0 = blo(q4.x), a1 = bhi(q4.x), a2 = blo(q4.y), a3 = bhi(q4.y);
        const float rq = __builtin_amdgcn_rsqf(wave_sum((a0 * a0 + a1 * a1) + (a2 * a2 + a3 * a3)) * (1.f / 256.f) + EPS);
        float c0 = blo(k2), c1 = bhi(k2);
        const float rk = __builtin_amdgcn_rsqf(wave_sum(c0 * c0 + c1 * c1) * (1.f / 128.f) + EPS);
        u32x2 qo; qo.x = cvtpk(a0 * rq, a1 * rq); qo.y = cvtpk(a2 * rq, a3 * rq);
        *((u32x2*)(pr + PC_CQ) + lane) = qo; *((unsigned*)(pr + PC_CKV) + lane) = cvtpk(c0 * rk, c1 * rk);
        float v = b2f(krv); const float vp = __shfl_xor(v, 8);
        if (row < NLAT) { const int t = row & 2047, j = lane & 31; const int pos = (j & 16) ? (t & 63) : (t >> 6);
            const int fi = j & 7; const float inv = __builtin_amdgcn_exp2f(-(float)fi * 1.660964047443681f);
            const float ang = (float)pos * inv; const float cs = __cosf(ang), sn = __sinf(ang);
            v = (j & 8) ? (v * cs + vp * sn) : (v * cs - vp * sn); }
        if (lane < 32) { const bf16 o = f2b(v); bf16* kp = Kb + (size_t)row * 768 + 64 + lane;
#pragma unroll
            for (int h = 0; h < 8; ++h) kp[h * 96] = o; }
    }
}
__device__ __forceinline__ void hg_finalize_row(int row, const bf16* Of, const bf16* Ob, const bf16* P, const f32x4 g0, const f32x4 g1, bf16* MIX, int lane) {
    const u32x4 a = *((const u32x4*)(Of + (size_t)row * 512) + lane), b = *((const u32x4*)(Ob + (size_t)row * 512) + lane), g = *((const u32x4*)(P + (size_t)row * NP + PC_HG) + lane);
    float o[8]; o[0] = blo(a.x) + blo(b.x); o[1] = bhi(a.x) + bhi(b.x); o[2] = blo(a.y) + blo(b.y); o[3] = bhi(a.y) + bhi(b.y); o[4] = blo(a.z) + blo(b.z); o[5] = bhi(a.z) + bhi(b.z); o[6] = blo(a.w) + blo(b.w); o[7] = bhi(a.w) + bhi(b.w);
    float gz[8]; gz[0] = blo(g.x); gz[1] = bhi(g.x); gz[2] = blo(g.y); gz[3] = bhi(g.y); gz[4] = blo(g.z); gz[5] = bhi(g.z); gz[6] = blo(g.w); gz[7] = bhi(g.w);
    float s = 0.f;
#pragma unroll
    for (int j = 0; j < 8; ++j) s += o[j] * o[j];
    s += __shfl_xor(s, 1); s += __shfl_xor(s, 2); s += __shfl_xor(s, 4); s += __shfl_xor(s, 8);
    const float rs = __builtin_amdgcn_rsqf(s * (1.f / 128.f) + EPS);
    const float gn[8] = {g0.x, g0.y, g0.z, g0.w, g1.x, g1.y, g1.z, g1.w};
    float r[8];
#pragma unroll
    for (int j = 0; j < 8; ++j) r[j] = o[j] * rs * gn[j] * (gz[j] * sigmoidf_(gz[j]));
    u32x4 w; w.x = cvtpk(r[0], r[1]); w.y = cvtpk(r[2], r[3]); w.z = cvtpk(r[4], r[5]); w.w = cvtpk(r[6], r[7]);
    *((u32x4*)(MIX + (size_t)row * 1024 + 512) + lane) = w;
}
constexpr int AT_KSTR = 208, AT_VSTR = 272, AT_KBYTES = 128 * AT_KSTR, AT_BUF = AT_KBYTES + 64 * AT_VSTR;
__device__ __forceinline__ void attn_unit(int b, int h, int qb, const bf16* __restrict__ Q, const bf16* __restrict__ Kb, const bf16* __restrict__ Vt, bf16* MIX, LAS unsigned char* lds, int tid, int lane, int wid) {
    const int r32 = lane & 31, hi = lane >> 5;
    const int tpos = qb * 256 + wid * 32 + r32; const size_t qrow = (size_t)b * 2048 + tpos;
    const bf16* Qp = Q + qrow * 768 + h * 96;
    bf16x8 qr[6];
#pragma unroll
    for (int d0 = 0; d0 < 4; ++d0) qr[d0] = *(const bf16x8*)(Qp + d0 * 16 + hi * 8);
#pragma unroll
    for (int hf = 0; hf < 2; ++hf) {
        const u32x4 x1 = *(const u32x4*)(Qp + 64 + hf * 16), x2 = *(const u32x4*)(Qp + 64 + hf * 16 + 8);
        const float pos = (float)(hf ? (tpos & 63) : (tpos >> 6));
        float o[8];
#pragma unroll
        for (int j = 0; j < 8; ++j) { const unsigned w1 = x1[j >> 1], w2 = x2[j >> 1]; const float a = (j & 1) ? bhi(w1) : blo(w1), bb = (j & 1) ? bhi(w2) : blo(w2);
            const float ang = pos * rope_inv(j); const float cs = __cosf(ang), sn = __sinf(ang);
            o[j] = hi ? (bb * cs + a * sn) : (a * cs - bb * sn); }
        u32x4 w; w.x = cvtpk(o[0], o[1]); w.y = cvtpk(o[2], o[3]); w.z = cvtpk(o[4], o[5]); w.w = cvtpk(o[6], o[7]);
        qr[4 + hf] = __builtin_bit_cast(bf16x8, w);
    }
    int kkey[3], kpart[3];
#pragma unroll
    for (int i = 0; i < 3; ++i) { const int ci = tid + 512 * i; kkey[i] = ci / 12; kpart[i] = ci % 12; }
    const int vd = tid >> 4, vc = tid & 15;
    const bf16* Vsrc = Vt + ((size_t)((b * 8 + h) * 64 + vd)) * NKEY + vc * 8;
    u32x4 kreg[3], vreg[2];
#define AT_LOAD(kt) do { const size_t krow0 = ((kt) < 16) ? (size_t)b * 2048 + (kt) * 128 : (size_t)NLAT + b * 256 + ((kt) - 16) * 128; \
        _Pragma("unroll") for (int i = 0; i < 3; ++i) kreg[i] = *(const u32x4*)(Kb + (krow0 + kkey[i]) * 768 + h * 96 + kpart[i] * 8); \
        vreg[0] = *(const u32x4*)(Vsrc + (kt) * 128); vreg[1] = *(const u32x4*)(Vsrc + (size_t)32 * NKEY + (kt) * 128); } while (0)
#define AT_STORE(bufo) do { _Pragma("unroll") for (int i = 0; i < 3; ++i) *(LAS u32x4*)(lds + (bufo) + kkey[i] * AT_KSTR + kpart[i] * 16) = kreg[i]; \
        *(LAS u32x4*)(lds + (bufo) + AT_KBYTES + vd * AT_VSTR + vc * 16) = vreg[0]; *(LAS u32x4*)(lds + (bufo) + AT_KBYTES + (32 + vd) * AT_VSTR + vc * 16) = vreg[1]; } while (0)
    AT_LOAD(0); AT_STORE(0);
    LDS_BARRIER();
    float m_run = 0.f, l_run = 0.f; f32x16 o0 = {}, o1 = {}, negm = {};
    constexpr int NT = NKEY / 128;
    for (int kt = 0; kt < NT; ++kt) {
        const int bufo = (kt & 1) * AT_BUF;
        if (kt + 1 < NT) AT_LOAD(kt + 1);
        f32x16 pa0, pa1, pc0, pc1;
        {
            const LAS unsigned char* kb = lds + bufo + r32 * AT_KSTR + hi * 16;
            { const bf16x8 a0 = *(const LAS bf16x8*)(kb), a1 = *(const LAS bf16x8*)(kb + 32 * AT_KSTR), a2 = *(const LAS bf16x8*)(kb + 64 * AT_KSTR), a3 = *(const LAS bf16x8*)(kb + 96 * AT_KSTR);
              pa0 = __builtin_amdgcn_mfma_f32_32x32x16_bf16(a0, qr[0], negm, 0, 0, 0); pa1 = __builtin_amdgcn_mfma_f32_32x32x16_bf16(a1, qr[0], negm, 0, 0, 0);
              pc0 = __builtin_amdgcn_mfma_f32_32x32x16_bf16(a2, qr[0], negm, 0, 0, 0); pc1 = __builtin_amdgcn_mfma_f32_32x32x16_bf16(a3, qr[0], negm, 0, 0, 0); }
#pragma unroll
            for (int d0 = 1; d0 < 6; ++d0) {
                const bf16x8 a0 = *(const LAS bf16x8*)(kb + d0 * 32), a1 = *(const LAS bf16x8*)(kb + 32 * AT_KSTR + d0 * 32), a2 = *(const LAS bf16x8*)(kb + 64 * AT_KSTR + d0 * 32), a3 = *(const LAS bf16x8*)(kb + 96 * AT_KSTR + d0 * 32);
                pa0 = __builtin_amdgcn_mfma_f32_32x32x16_bf16(a0, qr[d0], pa0, 0, 0, 0); pa1 = __builtin_amdgcn_mfma_f32_32x32x16_bf16(a1, qr[d0], pa1, 0, 0, 0);
                pc0 = __builtin_amdgcn_mfma_f32_32x32x16_bf16(a2, qr[d0], pc0, 0, 0, 0); pc1 = __builtin_amdgcn_mfma_f32_32x32x16_bf16(a3, qr[d0], pc1, 0, 0, 0);
            }
        }
        float mt = fmaxf(fmaxf(pa0[0], pa1[0]), fmaxf(pc0[0], pc1[0]));
#pragma unroll
        for (int r = 1; r < 16; ++r) mt = fmaxf(mt, fmaxf(fmaxf(pa0[r], pa1[r]), fmaxf(pc0[r], pc1[r])));
        mt = fmaxf(mt, __shfl_xor(mt, 32));
        const bool first = (kt == 0);
        if (first || __any(mt > 8.f)) {
            const float delta = first ? mt : fmaxf(mt, 0.f); const float alpha = first ? 1.f : __builtin_amdgcn_exp2f(-delta);
            m_run += delta; l_run *= alpha;
#pragma unroll
            for (int r = 0; r < 16; ++r) { pa0[r] -= delta; pa1[r] -= delta; pc0[r] -= delta; pc1[r] -= delta; o0[r] *= alpha; o1[r] *= alpha; negm[r] = -m_run; }
        }
#define AT_HALF(P0, P1, sub) do { float ls0 = 0.f, ls1 = 0.f; \
            _Pragma("unroll") for (int r = 0; r < 16; ++r) { P0[r] = __builtin_amdgcn_exp2f(P0[r]); P1[r] = __builtin_amdgcn_exp2f(P1[r]); ls0 += P0[r]; ls1 += P1[r]; } \
            l_run += ls0 + ls1; \
            bf16x8 pb[2][2]; \
            _Pragma("unroll") for (int s = 0; s < 2; ++s) { \
                u32x4 w; w.x = cvtpk(P0[8 * s + 0], P0[8 * s + 1]); w.y = cvtpk(P0[8 * s + 2], P0[8 * s + 3]); w.z = cvtpk(P0[8 * s + 4], P0[8 * s + 5]); w.w = cvtpk(P0[8 * s + 6], P0[8 * s + 7]); pb[0][s] = __builtin_bit_cast(bf16x8, w); \
                u32x4 y; y.x = cvtpk(P1[8 * s + 0], P1[8 * s + 1]); y.y = cvtpk(P1[8 * s + 2], P1[8 * s + 3]); y.z = cvtpk(P1[8 * s + 4], P1[8 * s + 5]); y.w = cvtpk(P1[8 * s + 6], P1[8 * s + 7]); pb[1][s] = __builtin_bit_cast(bf16x8, y); } \
            const LAS unsigned char* vb = lds + bufo + AT_KBYTES + r32 * AT_VSTR + (sub) * 128 + hi * 16; \
            _Pragma("unroll") for (int X = 0; X < 2; ++X) _Pragma("unroll") for (int s = 0; s < 2; ++s) { const int ko = (32 * X + 16 * s) * 2; \
                const bf16x8 a0 = *(const LAS bf16x8*)(vb + ko), a1 = *(const LAS bf16x8*)(vb + 32 * AT_VSTR + ko); \
                o0 = __builtin_amdgcn_mfma_f32_32x32x16_bf16(a0, pb[X][s], o0, 0, 0, 0); o1 = __builtin_amdgcn_mfma_f32_32x32x16_bf16(a1, pb[X][s], o1, 0, 0, 0); } } while (0)
        AT_HALF(pa0, pa1, 0);
        AT_HALF(pc0, pc1, 1);
#undef AT_HALF
        if (kt + 1 < NT) AT_STORE(((kt + 1) & 1) * AT_BUF);
        LDS_BARRIER();
    }
#undef AT_LOAD
#undef AT_STORE
    const float linv = __builtin_amdgcn_rcpf(l_run + __shfl_xor(l_run, 32));
    bf16* Op = MIX + qrow * 1024 + h * 64 + 4 * hi;
#pragma unroll
    for (int g = 0; g < 4; ++g) {
        u32x2 w0; w0.x = cvtpk(o0[4 * g] * linv, o0[4 * g + 1] * linv); w0.y = cvtpk(o0[4 * g + 2] * linv, o0[4 * g + 3] * linv); *(u32x2*)(Op + 8 * g) = w0;
        u32x2 w1; w1.x = cvtpk(o1[4 * g] * linv, o1[4 * g + 1] * linv); w1.y = cvtpk(o1[4 * g + 2] * linv, o1[4 * g + 3] * linv); *(u32x2*)(Op + 32 + 8 * g) = w1;
    }
}

constexpr int HG_QT = 0, HG_KT = 17408, HG_QH = 34816, HG_KHT = 52224, HG_VT = 70656, HG_AM = 89088, HG_ST = 98304, HG_DK = 133120, HG_PART = 133632;
__device__ __forceinline__ void hgrn_unit(int u, const bf16* __restrict__ P, bf16* Of, bf16* Ob, LAS unsigned char* lds, int tid, int lane, int wid) {
    const int dir = u & 1, h = (u >> 1) & 3, b = u >> 3;
    const int r32 = lane & 31, hi = lane >> 5;
    const int k0 = 2 * lane, tq = wid;
    const int qcol = PC_HQ + h * 128 + k0, zcol = (dir ? PC_HB : PC_HF) + h * 128 + k0, vcol = PC_HI + h * 128;
    const int vs = tid >> 4, vc16 = tid & 15;
    bf16* Od = dir ? Ob : Of;
    LAS bf16* Qt = (LAS bf16*)(lds + HG_QT); LAS bf16* Kt = (LAS bf16*)(lds + HG_KT); LAS bf16* Qh = (LAS bf16*)(lds + HG_QH); LAS bf16* KhT = (LAS bf16*)(lds + HG_KHT);
    LAS bf16* Vl = (LAS bf16*)(lds + HG_VT); LAS bf16* Am = (LAS bf16*)(lds + HG_AM); LAS bf16* St = (LAS bf16*)(lds + HG_ST); LAS float* dk = (LAS float*)(lds + HG_DK); LAS float* part = (LAS float*)(lds + HG_PART);
    f32x16 S0 = {}, S1 = {};
    for (int i = tid; i < 128 * 136 / 2; i += 512) ((LAS unsigned*)St)[i] = 0u;
    unsigned qv[8], zv[8]; u32x4 vv0, vv1;
#define HG_ROW0(ci) ((dir == 0) ? (((ci) < 4) ? (size_t)NLAT + b * 256 + (ci) * 64 : (size_t)b * 2048 + ((ci) - 4) * 64) : (((ci) < 4) ? (size_t)NLAT + b * 256 + (3 - (ci)) * 64 : (size_t)b * 2048 + (35 - (ci)) * 64))
#define HG_LOAD(ci) do { const bf16* pb_ = P + (HG_ROW0(ci) + 8 * tq) * NP; \
        _Pragma("unroll") for (int j = 0; j < 8; ++j) { qv[j] = *(const unsigned*)(pb_ + (size_t)j * NP + qcol); zv[j] = *(const unsigned*)(pb_ + (size_t)j * NP + zcol); } \
        vv0 = *(const u32x4*)(P + (HG_ROW0(ci) + vs) * NP + vcol + vc16 * 8); vv1 = *(const u32x4*)(P + (HG_ROW0(ci) + 32 + vs) * NP + vcol + vc16 * 8); } while (0)
#define HG_VPUT(vv, s_) do { Vl[(8 * vc16 + 0) * 72 + (s_)] = (bf16)((vv).x & 0xffffu); Vl[(8 * vc16 + 1) * 72 + (s_)] = (bf16)((vv).x >> 16); Vl[(8 * vc16 + 2) * 72 + (s_)] = (bf16)((vv).y & 0xffffu); Vl[(8 * vc16 + 3) * 72 + (s_)] = (bf16)((vv).y >> 16); \
        Vl[(8 * vc16 + 4) * 72 + (s_)] = (bf16)((vv).z & 0xffffu); Vl[(8 * vc16 + 5) * 72 + (s_)] = (bf16)((vv).z >> 16); Vl[(8 * vc16 + 6) * 72 + (s_)] = (bf16)((vv).w & 0xffffu); Vl[(8 * vc16 + 7) * 72 + (s_)] = (bf16)((vv).w >> 16); } while (0)
    HG_LOAD(0);
    for (int ci = 0; ci < 36; ++ci) {
        const size_t row0 = HG_ROW0(ci);
        float c0[8], c1[8], kk0[8], kk1[8], q0[8], q1[8];
#pragma unroll
        for (int j = 0; j < 8; ++j) { c0[j] = blo(zv[j]); c1[j] = bhi(zv[j]); kk0[j] = 1.f - __expf(c0[j]); kk1[j] = 1.f - __expf(c1[j]); q0[j] = blo(qv[j]); q1[j] = bhi(qv[j]); }
        if (dir == 0) {
#pragma unroll
            for (int j = 1; j < 8; ++j) { c0[j] += c0[j - 1]; c1[j] += c1[j - 1]; }
            *(LAS f32x2_t*)(part + tq * 128 + k0) = (f32x2_t){c0[7], c1[7]};
        } else {
#pragma unroll
            for (int j = 6; j >= 0; --j) { c0[j] += c0[j + 1]; c1[j] += c1[j + 1]; }
            *(LAS f32x2_t*)(part + tq * 128 + k0) = (f32x2_t){c0[0], c1[0]};
        }
        LDS_BARRIER();
        {
            float tot0 = 0.f, tot1 = 0.f, off0 = 0.f, off1 = 0.f, ref0 = 0.f, ref1 = 0.f;
#pragma unroll
            for (int i = 0; i < 8; ++i) { const f32x2_t pp = *(const LAS f32x2_t*)(part + i * 128 + k0); tot0 += pp.x; tot1 += pp.y;
                const bool before = dir ? (i > tq) : (i < tq); const bool inref = dir ? (i >= 4) : (i < 4);
                off0 += before ? pp.x : 0.f; off1 += before ? pp.y : 0.f; ref0 += inref ? pp.x : 0.f; ref1 += inref ? pp.y : 0.f; }
            const float eref0 = __expf(ref0), eref1 = __expf(ref1), etr0 = __expf(tot0 - ref0), etr1 = __expf(tot1 - ref1);
            off0 -= ref0; off1 -= ref1;
            float kh0[8], kh1[8];
#pragma unroll
            for (int j = 0; j < 8; ++j) { const float E0 = __expf(off0 + c0[j]), E1 = __expf(off1 + c1[j]); const float qt0 = q0[j] * E0, qt1 = q1[j] * E1, kt0 = kk0[j] * __builtin_amdgcn_rcpf(E0), kt1 = kk1[j] * __builtin_amdgcn_rcpf(E1);
                const int t = 8 * tq + j;
                *(LAS unsigned*)(Qt + t * 136 + k0) = cvtpk(qt0, qt1); *(LAS unsigned*)(Kt + t * 136 + k0) = cvtpk(kt0, kt1); *(LAS unsigned*)(Qh + t * 136 + k0) = cvtpk(qt0 * eref0, qt1 * eref1);
                kh0[j] = kt0 * etr0; kh1[j] = kt1 * etr1; }
            u32x4 w0, w1; w0.x = cvtpk(kh0[0], kh0[1]); w0.y = cvtpk(kh0[2], kh0[3]); w0.z = cvtpk(kh0[4], kh0[5]); w0.w = cvtpk(kh0[6], kh0[7]); w1.x = cvtpk(kh1[0], kh1[1]); w1.y = cvtpk(kh1[2], kh1[3]); w1.z = cvtpk(kh1[4], kh1[5]); w1.w = cvtpk(kh1[6], kh1[7]);
            *(LAS u32x4*)(KhT + k0 * 72 + 8 * tq) = w0; *(LAS u32x4*)(KhT + (k0 + 1) * 72 + 8 * tq) = w1;
            if (tq == 0) *(LAS f32x2_t*)(dk + k0) = (f32x2_t){__expf(tot0), __expf(tot1)};
            HG_VPUT(vv0, vs); HG_VPUT(vv1, 32 + vs);
        }
        if (ci + 1 < 36) HG_LOAD(ci + 1);
        LDS_BARRIER();
        if (wid < 4) {
            const int ti = wid >> 1, cj = wid & 1;
            f32x16 a = {};
            const LAS bf16* ap = Kt + (32 * cj + r32) * 136 + 8 * hi; const LAS bf16* bp = Qt + (32 * ti + r32) * 136 + 8 * hi;
#pragma unroll
            for (int ks = 0; ks < 8; ++ks) a = __builtin_amdgcn_mfma_f32_32x32x16_bf16(*(const LAS bf16x8*)(ap + 16 * ks), *(const LAS bf16x8*)(bp + 16 * ks), a, 0, 0, 0);
            const int t_ = 32 * ti + r32;
#pragma unroll
            for (int g = 0; g < 4; ++g) { float v[4];
#pragma unroll
                for (int e = 0; e < 4; ++e) { const int s_ = 32 * cj + 8 * g + 4 * hi + e; const bool keep = dir ? (s_ >= t_) : (s_ <= t_); v[e] = keep ? a[4 * g + e] : 0.f; }
                u32x2 w; w.x = cvtpk(v[0], v[1]); w.y = cvtpk(v[2], v[3]); *(LAS u32x2*)(Am + t_ * 72 + 32 * cj + 8 * g + 4 * hi) = w; }
        }
        const int oi = wid >> 2, nj = wid & 3;
        f32x16 oacc = {};
        {
            const LAS bf16* ap = St + (32 * nj + r32) * 136 + 8 * hi; const LAS bf16* bp = Qh + (32 * oi + r32) * 136 + 8 * hi;
#pragma unroll
            for (int ks = 0; ks < 8; ++ks) oacc = __builtin_amdgcn_mfma_f32_32x32x16_bf16(*(const LAS bf16x8*)(ap + 16 * ks), *(const LAS bf16x8*)(bp + 16 * ks), oacc, 0, 0, 0);
        }
        LDS_BARRIER();
        {
            const LAS bf16* ap = Vl + (32 * nj + r32) * 72 + 8 * hi; const LAS bf16* bp = Am + (32 * oi + r32) * 72 + 8 * hi;
#pragma unroll
            for (int ks = 0; ks < 4; ++ks) oacc = __builtin_amdgcn_mfma_f32_32x32x16_bf16(*(const LAS bf16x8*)(ap + 16 * ks), *(const LAS bf16x8*)(bp + 16 * ks), oacc, 0, 0, 0);
            if (ci >= 4) { bf16* op = Od + (row0 + 32 * oi + r32) * 512 + h * 128 + 32 * nj + 4 * hi;
#pragma unroll
                for (int g = 0; g < 4; ++g) { u32x2 w; w.x = cvtpk(oacc[4 * g], oacc[4 * g + 1]); w.y = cvtpk(oacc[4 * g + 2], oacc[4 * g + 3]); *(u32x2*)(op + 8 * g) = w; } }
        }
        {
            const int si = wid >> 1, sj0 = 2 * (wid & 1);
#pragma unroll
            for (int r = 0; r < 16; ++r) { const float d = dk[32 * si + (r & 3) + 8 * (r >> 2) + 4 * hi]; S0[r] *= d; S1[r] *= d; }
            const LAS bf16* ap = KhT + (32 * si + r32) * 72 + 8 * hi; const LAS bf16* bp0 = Vl + (32 * sj0 + r32) * 72 + 8 * hi; const LAS bf16* bp1 = bp0 + 32 * 72;
#pragma unroll
            for (int ks = 0; ks < 4; ++ks) { const bf16x8 av = *(const LAS bf16x8*)(ap + 16 * ks);
                S0 = __builtin_amdgcn_mfma_f32_32x32x16_bf16(av, *(const LAS bf16x8*)(bp0 + 16 * ks), S0, 0, 0, 0); S1 = __builtin_amdgcn_mfma_f32_32x32x16_bf16(av, *(const LAS bf16x8*)(bp1 + 16 * ks), S1, 0, 0, 0); }
            LAS bf16* sp0 = St + (32 * sj0 + r32) * 136 + 32 * si + 4 * hi; LAS bf16* sp1 = sp0 + 32 * 136;
#pragma unroll
            for (int g = 0; g < 4; ++g) { u32x2 w; w.x = cvtpk(S0[4 * g], S0[4 * g + 1]); w.y = cvtpk(S0[4 * g + 2], S0[4 * g + 3]); *(LAS u32x2*)(sp0 + 8 * g) = w;
                u32x2 y; y.x = cvtpk(S1[4 * g], S1[4 * g + 1]); y.y = cvtpk(S1[4 * g + 2], S1[4 * g + 3]); *(LAS u32x2*)(sp1 + 8 * g) = y; }
        }
        LDS_BARRIER();
    }
#undef HG_LOAD
#undef HG_ROW0
#undef HG_VPUT
}
#define XB_TMO      128
#define XB_XCNT(j)  (256  + 64 * (j))
#define XB_XSUB(j)  (1280 + 64 * (j))
#define XB_XGEN(j)  (2304 + 64 * (j))
#define XB_TOP      3328
#define XB_TOPGEN   3392
#define XCD_BAR_WORDS 3456
#define XB_SPIN_CAP (1u << 18)

__device__ __forceinline__ unsigned xb_ld(unsigned* p)              { return __hip_atomic_load(p, __ATOMIC_RELAXED, __HIP_MEMORY_SCOPE_AGENT); }
__device__ __forceinline__ unsigned xb_add(unsigned* p, unsigned v) { return __hip_atomic_fetch_add(p, v, __ATOMIC_RELAXED, __HIP_MEMORY_SCOPE_AGENT); }
__device__ __forceinline__ unsigned xb_xcc_id() { return (unsigned)__builtin_amdgcn_s_getreg((3 << 11) | 20) & 0xFu; }
#define XB_SPIN(cond, bar) do { unsigned _sp = 0; while (cond) { __builtin_amdgcn_s_sleep(1); \
    if ((++_sp & 255u) == 0u) { if (xb_ld(&(bar)[XB_TMO])) break; if (_sp > XB_SPIN_CAP) { atomicAdd(&(bar)[XB_TMO], 1u); break; } } } } while (0)

struct XcdBarrier {
    unsigned* bar; unsigned x;
    volatile LAS unsigned* st;
};

__device__ __forceinline__ XcdBarrier xcd_barrier_post(unsigned* bar, volatile LAS unsigned* st, int tid) {
    XcdBarrier b; b.bar = bar; b.x = xb_xcc_id(); b.st = st;
    if (tid == 0) (void)xb_add(&bar[XB_XCNT(b.x)], 1u);
    return b;
}
__device__ __forceinline__ void xcd_barrier_complete(unsigned* bar, unsigned x, unsigned& nloc, unsigned& nx) {
    const unsigned G = gridDim.x * gridDim.y * gridDim.z;
    unsigned sum, cnt, mine, sp = 0u;
    for (;;) {
        sum = 0u; cnt = 0u; mine = 0u;
#pragma unroll
        for (unsigned j = 0; j < 16; ++j) { const unsigned c = xb_ld(&bar[XB_XCNT(j)]); sum += c; cnt += (c > 0u) ? 1u : 0u; mine = (j == x) ? c : mine; }
        if (sum == G) break;
        __builtin_amdgcn_s_sleep(1);
        if ((++sp & 255u) == 0u) { if (xb_ld(&bar[XB_TMO])) break; if (sp > XB_SPIN_CAP) { atomicAdd(&bar[XB_TMO], 1u); break; } }
    }
    nloc = mine > 0u ? mine : 1u; nx = cnt > 0u ? cnt : 1u;
}

__device__ __forceinline__ void xcd_barrier(const XcdBarrier& b, int tid) {
    asm volatile("s_waitcnt vmcnt(0)" ::: "memory");
    __syncthreads();
    if (tid == 0) {
        unsigned* bar = b.bar;
        __builtin_amdgcn_s_waitcnt(0);
        unsigned nloc = b.st[0], nx = b.st[1];
        if (nloc == 0u) { xcd_barrier_complete(bar, b.x, nloc, nx); b.st[0] = nloc; b.st[1] = nx; }
        const unsigned old = xb_add(&bar[XB_XSUB(b.x)], 1u);
        const unsigned gen = old / nloc;
        if (old + 1u == (gen + 1u) * nloc) {
            __builtin_amdgcn_fence(__ATOMIC_RELEASE, "agent");
            asm volatile("s_waitcnt vmcnt(0)" ::: "memory");
            const unsigned og = xb_add(&bar[XB_TOP], 1u);
            const unsigned tg = og / nx;
            if (og + 1u == (tg + 1u) * nx) xb_add(&bar[XB_TOPGEN], 1u);
            else XB_SPIN(xb_ld(&bar[XB_TOPGEN]) == tg, bar);
            __builtin_amdgcn_fence(__ATOMIC_ACQUIRE, "agent");
            xb_add(&bar[XB_XGEN(b.x)], 1u);
            asm volatile("s_waitcnt vmcnt(0)" ::: "memory");
        } else {
            XB_SPIN(xb_ld(&bar[XB_XGEN(b.x)]) == gen, bar);
            __builtin_amdgcn_fence(__ATOMIC_ACQUIRE, "agent");
            asm volatile("s_waitcnt vmcnt(0)" ::: "memory");
        }
    }
    __syncthreads();
}

__global__ void __launch_bounds__(512) hymba_fwd(Params p) {
    extern __shared__ __attribute__((aligned(16))) unsigned char lds_raw[];
    LAS unsigned char* lds = (LAS unsigned char*)lds_raw;
    if (p.coop) { cg::grid_group grid = cg::this_grid(); grid.sync(); }
    const int G = gridDim.x; const int wave_s = __builtin_amdgcn_readfirstlane((int)threadIdx.x >> 6);
#define VCU() ((G % 8 == 0) ? ((int)blockIdx.x % 8) * (G / 8) + (int)blockIdx.x / 8 : (int)blockIdx.x)
#define TIDS() const int wave = wave_s, lane = lane_id_opaque(), tid = wave * 64 + lane
#define WSP(T, off) ((T*)(p.ws + (off)))
    const int lo = p.ph_lo, hi = p.ph_hi;
    unsigned xcc_s;
    { TIDS(); if (tid == 0) { ((volatile LAS unsigned*)(lds + LDS_BYTES - 64))[0] = 0u; ((volatile LAS unsigned*)(lds + LDS_BYTES - 64))[1] = 0u; }
      const XcdBarrier b0 = xcd_barrier_post((unsigned*)p.ws, (volatile LAS unsigned*)(lds + LDS_BYTES - 64), tid); xcc_s = b0.x; }
#define IN(k) (lo <= (k) && (k) < hi)
#define REPEAT(k) _Pragma("unroll") for (int rep__ = 0; rep__ < (((REP_MASK) >> (k)) & 1) + 1; ++rep__)
#define SEAM(k) do { if (IN(k) && IN((k) + 1)) { TIDS(); XcdBarrier bar_; bar_.bar = (unsigned*)p.ws; bar_.x = xcc_s; bar_.st = (volatile LAS unsigned*)(lds + LDS_BYTES - 64); xcd_barrier(bar_, tid); } } while (0)
    if (IN(0)) REPEAT(0) { TIDS(); p0_prologue(p, lds, tid, lane, wave); }
    SEAM(0);
    if (IN(1)) REPEAT(1) { TIDS(); norm_mod_rows(p.x, NLAT, p.ctx, NCTXR, p.norm_mix, WSP(float, WS_MOD), 0, 1024, WSP(bf16, WS_XN), lane, wave); }
    SEAM(1);
    if (IN(2)) REPEAT(2) { pg8::Gemm g{WSP(bf16, WS_XN), 1024, WSP(bf16, WS_WIN), MALL, NP, 1024}; pg8::StaticOrder S; S.init(MALL, NP, G, (int)blockIdx.x);
        pg8::EpiIn E{WSP(bf16, WS_P), p.hgrn_lb}; pg8::gemm_phase<pg8::EpiIn, pg8::StaticOrder, true, true>(lds, g, S, E, wave_s); }
    SEAM(2);
    if (IN(3)) { TIDS(); mla_prep_rows(WSP(bf16, WS_P), WSP(bf16, WS_K), lane, wave); }
    SEAM(3);
    if (IN(4)) REPEAT(4) {
        { pg8::Gemm g{WSP(bf16, WS_P) + PC_CQ, NP, WSP(bf16, WS_WUQ), NLAT, 768, 256}; pg8::StaticOrder S; S.init(NLAT, 768, G, (int)blockIdx.x);
          pg8::EpiBf16<0> E{WSP(bf16, WS_Q), 768, nullptr, 768, 0, QSCALE}; pg8::gemm_phase<pg8::EpiBf16<0>, pg8::StaticOrder, true, true>(lds, g, S, E, wave_s); }
        { pg8::Gemm g{WSP(bf16, WS_P) + PC_CKV, NP, WSP(bf16, WS_WUKV), MALL, 1024, 128}; pg8::StaticOrder S; S.init(MALL, 1024, G, (int)blockIdx.x);
          pg8::EpiKV E{WSP(bf16, WS_K), WSP(bf16, WS_VT)}; pg8::gemm_phase<pg8::EpiKV, pg8::StaticOrder, true, true>(lds, g, S, E, wave_s); }
    }
    SEAM(4);
    if (IN(5)) {
        { TIDS(); if ((((int)blockIdx.x >> 3) & 1) == 0) for (int u = ((int)blockIdx.x & 7) * (G >> 4) + ((int)blockIdx.x >> 4); u < 128; u += (G >> 1)) { hgrn_unit(u, WSP(bf16, WS_P), (bf16*)p.out, (bf16*)p.out + (size_t)NLAT * 512, lds, tid, lane, wave);
            asm volatile("s_waitcnt vmcnt(0)" ::: "memory"); __syncthreads();
            if (tid == 0) { __builtin_amdgcn_fence(__ATOMIC_RELEASE, "agent"); asm volatile("s_waitcnt vmcnt(0)" ::: "memory"); __hip_atomic_fetch_add((unsigned*)p.ws + 3648, 1u, __ATOMIC_RELAXED, __HIP_MEMORY_SCOPE_AGENT); } } }
        { TIDS(); volatile LAS unsigned* slot = (volatile LAS unsigned*)(lds + LDS_BYTES - 128);
          for (;;) {
              if (tid == 0) slot[0] = __hip_atomic_fetch_add((unsigned*)p.ws + 3584, 1u, __ATOMIC_RELAXED, __HIP_MEMORY_SCOPE_AGENT);
              __syncthreads(); const int u = (int)slot[0]; __syncthreads();
              if (u >= 1024) break;
              attn_unit(u >> 6, (u >> 3) & 7, u & 7, WSP(bf16, WS_Q), WSP(bf16, WS_K), WSP(bf16, WS_VT), WSP(bf16, WS_XN), lds, tid, lane, wave);
          }
          if (tid == 0) { unsigned sp = 0; while (__hip_atomic_load((unsigned*)p.ws + 3648, __ATOMIC_RELAXED, __HIP_MEMORY_SCOPE_AGENT) < 128u) { __builtin_amdgcn_s_sleep(8); if (++sp > (1u << 20)) break; }
              __builtin_amdgcn_fence(__ATOMIC_ACQUIRE, "agent"); asm volatile("s_waitcnt vmcnt(0)" ::: "memory"); }
          __syncthreads();
          { const float* hgn = p.hgrn_norm; const f32x4 g0 = *(const f32x4*)(hgn + (lane & 15) * 8), g1 = *(const f32x4*)(hgn + (lane & 15) * 8 + 4);
            for (;;) {
              if (tid == 0) slot[0] = __hip_atomic_fetch_add((unsigned*)p.ws + 3712, 1u, __ATOMIC_RELAXED, __HIP_MEMORY_SCOPE_AGENT);
              __syncthreads(); const int c = (int)slot[0]; __syncthreads();
              if (c >= 512) break;
#pragma unroll 2
              for (int r = 0; r < 8; ++r) hg_finalize_row(c * 64 + wave * 8 + r, (const bf16*)p.out, (const bf16*)p.out + (size_t)NLAT * 512, WSP(bf16, WS_P), g0, g1, WSP(bf16, WS_XN), lane);
            } }
        }
    }
    SEAM(5);
    if (IN(7)) REPEAT(7) { pg8::Gemm g{WSP(bf16, WS_XN), 1024, WSP(bf16, WS_WOUT), NLAT, 1024, 1024}; pg8::StaticOrder S; S.init(NLAT, 1024, G, (int)blockIdx.x);
        pg8::EpiRes E{p.x, p.out, WSP(float, WS_MOD) + 2048}; pg8::gemm_phase<pg8::EpiRes, pg8::StaticOrder, true, true>(lds, g, S, E, wave_s); }
    SEAM(7);
    if (IN(8)) REPEAT(8) { TIDS(); norm_mod_rows(p.out, NLAT, p.out, 0, p.norm_mlp, WSP(float, WS_MOD), 3072, 4096, WSP(bf16, WS_XN), lane, wave); }
    SEAM(8);
    if (IN(9)) REPEAT(9) { pg8::Gemm g{WSP(bf16, WS_XN), 1024, WSP(bf16, WS_W1), NLAT, DFF, 1024}; pg8::StaticOrder S; S.init(NLAT, DFF, G, (int)blockIdx.x);
        pg8::EpiRelu2 E{WSP(bf16, WS_HID), DFF}; pg8::gemm_phase<pg8::EpiRelu2, pg8::StaticOrder, true, true>(lds, g, S, E, wave_s); }
    SEAM(9);
    if (IN(10)) { pg8::Gemm g{WSP(bf16, WS_HID), DFF, WSP(bf16, WS_W2), NLAT, 1024, DFF}; pg8::StaticOrder S; S.init(NLAT, 1024, G, (int)blockIdx.x);
        pg8::EpiRes E{p.out, p.out, WSP(float, WS_MOD) + 5120}; pg8::gemm_phase<pg8::EpiRes, pg8::StaticOrder, true, true>(lds, g, S, E, wave_s); }
    SEAM(10);
#if REP_BAR
    _Pragma("unroll") for (int rb_ = 0; rb_ < 10; ++rb_) { TIDS(); XcdBarrier bar_; bar_.bar = (unsigned*)p.ws; bar_.x = xcc_s; bar_.st = (volatile LAS unsigned*)(lds + LDS_BYTES - 64); xcd_barrier(bar_, tid); }
#endif
    if (IN(11)) { TIDS(); final_norm_rows(p.out, NLAT, p.final_norm, lane, wave); }
#undef IN
#undef SEAM
}

#ifndef MK_SPLIT
#define MK_SPLIT 0
#endif
extern "C" void kernel_launch(void* const* d_in, const int* in_sizes, int n_in, void* d_out, int out_size, void* d_ws, size_t ws_size, hipStream_t stream) {
    static int grid = 0;
    if (grid == 0) {
        if (n_in != 19 || out_size != NLAT * DM || ws_size < WS_END) { fprintf(stderr, "kernel_launch: unexpected shapes (n_in %d, out %d, ws %zu)\n", n_in, out_size, ws_size); grid = -1; return; }
        int dev = 0, cus = 0, per_cu = 0;
        (void)hipGetDevice(&dev); (void)hipDeviceGetAttribute(&cus, hipDeviceAttributeMultiprocessorCount, dev);
        if (hipFuncSetAttribute((const void*)hymba_fwd, hipFuncAttributeMaxDynamicSharedMemorySize, LDS_BYTES) != hipSuccess) { fprintf(stderr, "kernel_launch: hipFuncSetAttribute failed\n"); grid = -1; return; }
        if (hipOccupancyMaxActiveBlocksPerMultiprocessor(&per_cu, (const void*)hymba_fwd, 512, LDS_BYTES) != hipSuccess || per_cu < 1) { fprintf(stderr, "kernel_launch: occupancy query says %d blocks per CU\n", per_cu); per_cu = 1; }
        (void)hipGetLastError();
        grid = cus > 0 ? cus : 256;
    }
    if (grid < 0) return;
    (void)hipMemsetAsync(d_ws, 0, 16384, stream);
    Params p{};
    p.x = (const float*)d_in[0]; p.c = (const float*)d_in[1]; p.ctx = (const float*)d_in[2]; p.c_ctx = (const float*)d_in[3]; p.w_ada = (const float*)d_in[4]; p.b_ada = (const float*)d_in[5];
    p.norm_mix = (const float*)d_in[6]; p.w_in = (const float*)d_in[7]; p.q_norm = (const float*)d_in[8]; p.w_uq = (const float*)d_in[9]; p.kv_norm = (const float*)d_in[10]; p.w_ukv = (const float*)d_in[11];
    p.hgrn_lb = (const float*)d_in[12]; p.hgrn_norm = (const float*)d_in[13]; p.w_out = (const float*)d_in[14]; p.norm_mlp = (const float*)d_in[15]; p.w_mlp_in = (const float*)d_in[16]; p.w_mlp_out = (const float*)d_in[17]; p.final_norm = (const float*)d_in[18];
    p.out = (float*)d_out; p.ws = (unsigned char*)d_ws;
#if MK_SPLIT
    p.coop = 0; for (int ph = 0; ph < 12; ++ph) { p.ph_lo = ph; p.ph_hi = ph + 1; hipLaunchKernelGGL(hymba_fwd, dim3(grid), dim3(512), LDS_BYTES, stream, p); }
#else
    p.ph_lo = 0; p.ph_hi = 12; p.coop = 1;
    void* args[] = {&p};
    hipError_t e = hipLaunchCooperativeKernel((const void*)hymba_fwd, dim3(grid), dim3(512), args, LDS_BYTES, stream);
    if (e != hipSuccess) fprintf(stderr, "kernel_launch: cooperative launch failed: %s (grid %d)\n", hipGetErrorString(e), grid);
#endif
}
```
